# Optimizing an MI355X kernel written in HIP

```python
import jax, jax.numpy as jnp
from jax import lax
import numpy as np

D_MODEL = 2048
BATCH = 2
SEQ = 16384
DEPTH = 2

GRID_W = 64
CTX_LEN = 256
RET_HEADS = 8
RET_QK_DIM = D_MODEL // RET_HEADS
RET_V_DIM = D_MODEL // RET_HEADS
RET_WIDTH = RET_HEADS * RET_QK_DIM
RET_CHUNK = 128
ROPE_HALF = RET_QK_DIM // 2
ROPE_FREQS = ROPE_HALF // 2
ROPE_BASE = 10000.0
LRU_WIDTH = D_MODEL
LRU_BLOCKS = 8
LRU_BLOCK_DIM = LRU_WIDTH // LRU_BLOCKS
LRU_C = 8.0
CONV_W = 4
CONV_PAD = (2, 1)
FFN_HIDDEN = ((8 * D_MODEL // 3 + 255) // 256) * 256
NORM_EPS = 1e-6
IN_SIZES = (RET_WIDTH,) * 4 + (LRU_WIDTH,) * 2 + (D_MODEL,) * 2
IN_COLS = sum(IN_SIZES)

kernel_name = 'hybrid_retention_rglru_diffusion_block'


def _normal(key, shape, scale):
    return jax.random.normal(key, shape, jnp.float32) * scale


def rms_norm(x, g):
    xf = x.astype(jnp.float32)
    y = xf * lax.rsqrt(jnp.mean(xf * xf, axis=-1, keepdims=True) + NORM_EPS)
    return (y * g.astype(jnp.float32)).astype(x.dtype)


def head_norm(o, g):
    b, h, n, dv = o.shape
    of = o.astype(jnp.float32)
    mu = jnp.mean(of, axis=-1, keepdims=True)
    var = jnp.mean(jnp.square(of - mu), axis=-1, keepdims=True)
    y = (of - mu) * lax.rsqrt(var + NORM_EPS)
    y = y.transpose(0, 2, 1, 3).reshape(b, n, h * dv) * g.astype(jnp.float32)
    return y.astype(o.dtype)


def to_heads(t):
    b, n, _ = t.shape
    return t.reshape(b, n, RET_HEADS, -1).transpose(0, 2, 1, 3)


def rope_tables(row, col):
    inv = ROPE_BASE ** (-jnp.arange(ROPE_FREQS, dtype=jnp.float32) / ROPE_FREQS)
    ang_r = row[:, None] * inv[None, :]
    ang_c = col[:, None] * inv[None, :]
    return (jnp.cos(ang_r), jnp.sin(ang_r), jnp.cos(ang_c), jnp.sin(ang_c))


def apply_rope_2d(t, cos_r, sin_r, cos_c, sin_c):
    def rot(p, cs, sn):
        cs = cs.astype(p.dtype)
        sn = sn.astype(p.dtype)
        p1, p2 = p[..., :ROPE_FREQS], p[..., ROPE_FREQS:]
        return jnp.concatenate([p1 * cs - p2 * sn, p1 * sn + p2 * cs], axis=-1)
    return jnp.concatenate([rot(t[..., :ROPE_HALF], cos_r, sin_r),
                            rot(t[..., ROPE_HALF:], cos_c, sin_c)], axis=-1)


def retention_scan(q, k, v, log_g, s0):
    b, h, n, _ = q.shape
    dv = v.shape[-1]
    nc = n // RET_CHUNK

    def chunks(t):
        return t.reshape(b, h, nc, RET_CHUNK, t.shape[-1]).transpose(2, 0, 1, 3, 4)

    idx = jnp.arange(RET_CHUNK, dtype=jnp.float32)
    diff = idx[:, None] - idx[None, :]
    lg = log_g.astype(jnp.float32)
    causal = diff >= 0
    decay_in = jnp.where(causal[None], jnp.exp(jnp.where(causal, diff, 0.0)[None] * lg[:, None, None]), 0.0).astype(q.dtype)
    decay_q = jnp.exp((idx + 1.0)[None, :] * lg[:, None]).astype(q.dtype)
    decay_k = jnp.exp((RET_CHUNK - 1.0 - idx)[None, :] * lg[:, None]).astype(q.dtype)
    decay_s = jnp.exp(RET_CHUNK * lg).astype(q.dtype)

    def step(s, qkv):
        qc, kc, vc = qkv
        att = jnp.einsum('bhid,bhjd->bhij', qc, kc) * decay_in
        o = (jnp.einsum('bhij,bhje->bhie', att, vc)
             + jnp.einsum('bhid,bhde->bhie', qc, s) * decay_q[None, :, :, None])
        s = s * decay_s[None, :, None, None] + jnp.einsum('bhjd,bhje->bhde', kc * decay_k[None, :, :, None], vc)
        return s, o

    s_fin, o = lax.scan(step, s0, (chunks(q), chunks(k), chunks(v)))
    o = o.transpose(1, 2, 0, 3, 4).reshape(b, h, n, dv)
    return o, s_fin


def bidir_retention(q, k, v, log_g, s0_f, s0_b):
    o_f, s_f = retention_scan(q, k, v, log_g[0], s0_f)
    fl = lambda t: jnp.flip(t, axis=2)
    o_b, s_b = retention_scan(fl(q), fl(k), fl(v), log_g[1], s0_b)
    return o_f + fl(o_b), s_f, s_b


def dwconv(x, w, bias):
    y = lax.conv_general_dilated(x, w[:, None, :].astype(x.dtype), window_strides=(1,), padding=[CONV_PAD],
                                 dimension_numbers=('NWC', 'WIO', 'NWC'), feature_group_count=x.shape[-1])
    return y + bias.astype(x.dtype)


def rglru_scan(x, w_a, b_a, w_x, b_x, lam, h0):
    xf = x.astype(jnp.float32)
    b, n, w = xf.shape
    xb = xf.reshape(b, n, LRU_BLOCKS, LRU_BLOCK_DIM)
    r = jax.nn.sigmoid(jnp.einsum('bnki,kij->bnkj', xb, w_a.astype(jnp.float32)).reshape(b, n, w) + b_a.astype(jnp.float32))
    i = jax.nn.sigmoid(jnp.einsum('bnki,kij->bnkj', xb, w_x.astype(jnp.float32)).reshape(b, n, w) + b_x.astype(jnp.float32))
    log_a = -LRU_C * r * jax.nn.softplus(-lam.astype(jnp.float32))
    a = jnp.exp(log_a)
    u = jnp.sqrt(-jnp.expm1(2.0 * log_a)) * (i * xf)
    u = u.at[:, 0].add(a[:, 0] * h0)

    def comb(lhs, rhs):
        a1, b1 = lhs
        a2, b2 = rhs
        return a1 * a2, a2 * b1 + b2

    _, h = lax.associative_scan(comb, (a, u), axis=1)
    return h, h[:, -1]


def bidir_rglru(x, w_a, b_a, w_x, b_x, lam, h0_f, h0_b):
    h_f, hf_fin = rglru_scan(x, w_a[0], b_a[0], w_x[0], b_x[0], lam[0], h0_f)
    h_b, hb_fin = rglru_scan(jnp.flip(x, axis=1), w_a[1], b_a[1], w_x[1], b_x[1], lam[1], h0_b)
    return h_f + jnp.flip(h_b, axis=1), hf_fin, hb_fin


def token_mixer(h_lat, h_ctx, rope, w_in, b_in, ret_decay, ret_gn, conv_w, conv_b,
                lru_wa, lru_ba, lru_wx, lru_bx, lru_lambda, w_ret_o, w_lru_o, w_out, with_ctx):
    splits = [int(s) for s in np.cumsum(IN_SIZES)[:-1]]
    pl = jnp.split(h_lat @ w_in + b_in, splits, axis=-1)
    pc = jnp.split(h_ctx @ w_in + b_in, splits, axis=-1)
    b = h_lat.shape[0]

    log_g = jax.nn.log_sigmoid(ret_decay.astype(jnp.float32))
    k_scale = RET_QK_DIM ** -0.5
    qc, kc, vc = to_heads(pc[0]), to_heads(pc[1]) * k_scale, to_heads(pc[2])
    ql = apply_rope_2d(to_heads(pl[0]), *rope)
    kl = apply_rope_2d(to_heads(pl[1]), *rope) * k_scale
    vl = to_heads(pl[2])
    s0 = jnp.zeros((b, RET_HEADS, RET_QK_DIM, RET_V_DIM), qc.dtype)
    o_c, s_f, s_b = bidir_retention(qc, kc, vc, log_g, s0, s0)
    o_l, _, _ = bidir_retention(ql, kl, vl, log_g, s_f, s_b)

    xc = dwconv(pc[4], conv_w, conv_b)
    xl = dwconv(pl[4], conv_w, conv_b)
    h0 = jnp.zeros((b, LRU_WIDTH), jnp.float32)
    r_c, hf, hb = bidir_rglru(xc, lru_wa, lru_ba, lru_wx, lru_bx, lru_lambda, h0, h0)
    r_l, _, _ = bidir_rglru(xl, lru_wa, lru_ba, lru_wx, lru_bx, lru_lambda, hf, hb)

    def merge(o, p, r):
        y_r = jax.nn.silu(p[3]) * head_norm(o, ret_gn)
        y_l = r.astype(p[5].dtype) * jax.nn.gelu(p[5])
        y = jax.nn.sigmoid(p[6]) * (y_r @ w_ret_o) + jax.nn.sigmoid(p[7]) * (y_l @ w_lru_o)
        return y @ w_out

    y_lat = merge(o_l, pl, r_l)
    y_ctx = merge(o_c, pc, r_c) if with_ctx else None
    return y_lat, y_ctx


def swiglu(h, w_ffn_in, w_ffn_out):
    a, g = jnp.split(h @ w_ffn_in, 2, axis=-1)
    return (jax.nn.silu(a) * g) @ w_ffn_out


def setup_inputs(seed: int = 0) -> dict:
    key = jax.random.key(seed)
    ks = jax.random.split(key, 26)
    f32 = jnp.float32
    base = 1.0 - 2.0 ** (-5.0 - jnp.arange(RET_HEADS, dtype=f32))
    ret_decay = (jnp.broadcast_to(jnp.log(base) - jnp.log1p(-base), (DEPTH, 2, RET_HEADS))
                 + _normal(ks[12], (DEPTH, 2, RET_HEADS), 0.01))
    u = jax.random.uniform(ks[20], (DEPTH, 2, LRU_WIDTH), f32, 0.9, 0.999)
    s = u ** (1.0 / LRU_C)
    lru_lambda = jnp.log(s) - jnp.log1p(-s)
    return {
        'x': _normal(ks[0], (BATCH, SEQ, D_MODEL), 1.0),
        'c': _normal(ks[1], (BATCH, D_MODEL), 1.0),
        'ctx': _normal(ks[2], (BATCH, CTX_LEN, D_MODEL), 1.0),
        'c_ctx': _normal(ks[3], (D_MODEL,), 1.0),
        'w_mod': _normal(ks[4], (DEPTH, D_MODEL, 6 * D_MODEL), 0.5 * D_MODEL ** -0.5),
        'b_mod': _normal(ks[5], (DEPTH, 6 * D_MODEL), 0.02),
        'g_pre_mix': 1.0 + _normal(ks[6], (DEPTH, D_MODEL), 0.02),
        'g_post_mix': 1.0 + _normal(ks[7], (DEPTH, D_MODEL), 0.02),
        'g_pre_ffn': 1.0 + _normal(ks[8], (DEPTH, D_MODEL), 0.02),
        'g_post_ffn': 1.0 + _normal(ks[9], (DEPTH, D_MODEL), 0.02),
        'w_in': _normal(ks[10], (DEPTH, D_MODEL, IN_COLS), D_MODEL ** -0.5),
        'b_in': _normal(ks[11], (DEPTH, IN_COLS), 0.02),
        'ret_decay': ret_decay,
        'ret_gn': 1.0 + _normal(ks[13], (DEPTH, RET_WIDTH), 0.02),
        'conv_w': _normal(ks[14], (DEPTH, CONV_W, LRU_WIDTH), CONV_W ** -0.5),
        'conv_b': _normal(ks[15], (DEPTH, LRU_WIDTH), 0.02),
        'lru_wa': _normal(ks[16], (DEPTH, 2, LRU_BLOCKS, LRU_BLOCK_DIM, LRU_BLOCK_DIM), LRU_BLOCK_DIM ** -0.5),
        'lru_ba': _normal(ks[17], (DEPTH, 2, LRU_WIDTH), 0.02),
        'lru_wx': _normal(ks[18], (DEPTH, 2, LRU_BLOCKS, LRU_BLOCK_DIM, LRU_BLOCK_DIM), LRU_BLOCK_DIM ** -0.5),
        'lru_bx': _normal(ks[19], (DEPTH, 2, LRU_WIDTH), 0.02),
        'lru_lambda': lru_lambda,
        'w_ret_o': _normal(ks[21], (DEPTH, RET_WIDTH, D_MODEL), RET_WIDTH ** -0.5),
        'w_lru_o': _normal(ks[22], (DEPTH, LRU_WIDTH, D_MODEL), LRU_WIDTH ** -0.5),
        'w_out': _normal(ks[23], (DEPTH, D_MODEL, D_MODEL), D_MODEL ** -0.5),
        'w_ffn_in': _normal(ks[24], (DEPTH, D_MODEL, 2 * FFN_HIDDEN), D_MODEL ** -0.5),
        'w_ffn_out': _normal(ks[25], (DEPTH, FFN_HIDDEN, D_MODEL), FFN_HIDDEN ** -0.5),
    }


def reference(x, c, ctx, c_ctx, w_mod, b_mod, g_pre_mix, g_post_mix, g_pre_ffn, g_post_ffn,
              w_in, b_in, ret_decay, ret_gn, conv_w, conv_b, lru_wa, lru_ba, lru_wx, lru_bx,
              lru_lambda, w_ret_o, w_lru_o, w_out, w_ffn_in, w_ffn_out):
    n = x.shape[1]
    rows = n // GRID_W
    row = jnp.repeat(jnp.arange(rows, dtype=jnp.float32), GRID_W)
    col = jnp.tile(jnp.arange(GRID_W, dtype=jnp.float32), rows)
    rope = rope_tables(row, col)
    for l in range(DEPTH):
        with_ctx = l < DEPTH - 1
        m_lat = (jax.nn.silu(c) @ w_mod[l] + b_mod[l])[:, None, :]
        m_ctx = jax.nn.silu(c_ctx) @ w_mod[l] + b_mod[l]
        sh1, sc1, ga1, sh2, sc2, ga2 = jnp.split(m_lat, 6, axis=-1)
        csh1, csc1, cga1, csh2, csc2, cga2 = jnp.split(m_ctx, 6, axis=-1)

        h_lat = rms_norm(x, g_pre_mix[l]) * (1.0 + sc1) + sh1
        h_ctx = rms_norm(ctx, g_pre_mix[l]) * (1.0 + csc1) + csh1
        y_lat, y_ctx = token_mixer(h_lat, h_ctx, rope, w_in[l], b_in[l], ret_decay[l], ret_gn[l],
                                   conv_w[l], conv_b[l], lru_wa[l], lru_ba[l], lru_wx[l], lru_bx[l],
                                   lru_lambda[l], w_ret_o[l], w_lru_o[l], w_out[l], with_ctx)
        x = x + ga1 * rms_norm(y_lat, g_post_mix[l])
        f_lat = swiglu(rms_norm(x, g_pre_ffn[l]) * (1.0 + sc2) + sh2, w_ffn_in[l], w_ffn_out[l])
        x = x + ga2 * rms_norm(f_lat, g_post_ffn[l])

        if with_ctx:
            ctx = ctx + cga1 * rms_norm(y_ctx, g_post_mix[l])
            f_ctx = swiglu(rms_norm(ctx, g_pre_ffn[l]) * (1.0 + csc2) + csh2, w_ffn_in[l], w_ffn_out[l])
            ctx = ctx + cga2 * rms_norm(f_ctx, g_post_ffn[l])
    return x
```

```cpp
#include <hip/hip_runtime.h>
#include <cstdio>
#include <cstdint>

#ifndef MK_PER_PHASE
#define MK_PER_PHASE 0
#endif

#define LAS __attribute__((address_space(3)))
#define GAS __attribute__((address_space(1)))
typedef unsigned short bf16_t;
typedef short bf16x8 __attribute__((ext_vector_type(8)));
typedef float f32x4 __attribute__((ext_vector_type(4)));
typedef float f32x2 __attribute__((ext_vector_type(2)));
typedef unsigned u32x4 __attribute__((ext_vector_type(4)));
typedef unsigned u32x2 __attribute__((ext_vector_type(2)));

constexpr int DM = 2048, NBATCH = 2, SEQ = 16384, CTXL = 256, DEPTH = 2, NH = 8, HD = 256, FFH = 5632, INC = 16384;
constexpr int MLAT = NBATCH * SEQ, MCTX = NBATCH * CTXL;
constexpr int LCH = 128;
constexpr float EPS = 1e-6f;
constexpr size_t MiB = 1u << 20;
constexpr size_t WS_CTL = 0, CTL_ZERO_BYTES = 1 * MiB;
constexpr size_t WS_MOD = 1 * MiB;
constexpr size_t WS_ROPE = 2 * MiB;
constexpr size_t WS_PS = 3 * MiB, WS_HE = 5 * MiB;
constexpr size_t WS_HST = 7 * MiB;
constexpr size_t WS_STATS = 8 * MiB;
constexpr size_t WS_SST = 12 * MiB;
constexpr size_t WS_CTXS = 20 * MiB;
constexpr size_t WS_HCTX = 24 * MiB;
constexpr size_t WS_VEC = 26 * MiB;
constexpr size_t WS_PT = 28 * MiB, WS_HT = 32 * MiB;
constexpr size_t WS_WIN = 36 * MiB;
constexpr size_t WS_WRO = WS_WIN + 64 * MiB, WS_WLO = WS_WRO + 8 * MiB, WS_WOUT = WS_WLO + 8 * MiB;
constexpr size_t WS_WG = WS_WOUT + 8 * MiB;
constexpr size_t WS_WF1 = WS_WG + 4 * MiB;
constexpr size_t WS_WF2 = WS_WF1 + 44 * MiB;
constexpr size_t WS_HLAT = WS_WF2 + 22 * MiB;
constexpr size_t WS_SLOTS = WS_HLAT + 128 * MiB;
constexpr size_t SLOT = 64 * MiB;
constexpr int NSLOT = 11;
constexpr size_t WS_END = WS_SLOTS + NSLOT * SLOT;
static_assert(WS_WF2 + 22 * MiB == WS_HLAT && WS_END <= 1084 * MiB, "ws map");
constexpr int CW_BAR = 4096;
constexpr int VEC_BINP = 0, VEC_CL = 16384, VEC_LG2 = 16384 + 4096;

constexpr int RING_BYTES = 131072, LDSCTL_OFF = RING_BYTES, MISC_OFF = LDSCTL_OFF + 320, PTR_OFF = LDSCTL_OFF + 1024, LDS_BYTES = 147456;

#ifndef EPI_NT
#define EPI_NT 0
#endif
#if EPI_NT
#define ST16(p, w) __builtin_nontemporal_store((w), (u32x4*)(p))
#else
#define ST16(p, w) (*(u32x4*)(p) = (w))
#endif
__device__ __forceinline__ unsigned cvt_pk_bf16(float lo, float hi) { unsigned r; asm volatile("v_cvt_pk_bf16_f32 %0, %1, %2" : "=v"(r) : "v"(lo), "v"(hi)); return r; }
__device__ __forceinline__ float bf_lo(unsigned w) { return __uint_as_float(w << 16); }
__device__ __forceinline__ float bf_hi(unsigned w) { return __uint_as_float(w & 0xffff0000u); }
__device__ __forceinline__ float fexp(float x) { return __builtin_amdgcn_exp2f(x * 1.44269504089f); }
__device__ __forceinline__ float flog1p(float e) { const float u = 1.0f + e; return u == 1.0f ? e : (__builtin_amdgcn_logf(u) * 0.69314718056f) * e * __builtin_amdgcn_rcpf(u - 1.0f); }
__device__ __forceinline__ float fsigmoid(float x) { return __builtin_amdgcn_rcpf(1.0f + fexp(-x)); }
__device__ __forceinline__ float fsilu(float x) { return x * fsigmoid(x); }
__device__ __forceinline__ float fgelu(float x) { const float u = 0.7978845608f * (x + 0.044715f * x * x * x); return x * fsigmoid(2.0f * u); }
__device__ __forceinline__ float wave_sum(float v) {
#pragma unroll
    for (int o = 1; o < 64; o <<= 1) v += __shfl_xor(v, o);
    return v;
}

namespace pg8 {
constexpr int BM = 256, BK = 64, HALF = 128, HTB = HALF * BK * 2, STAGE_BYTES = 8 * HTB, NXCD = 8, WGM = 8;
__host__ __device__ __forceinline__ int lds_byte(int r, int c) { const int st = (r >> 4) * 2 + (c >> 5), rr = r & 15, cc = c & 31, ob = rr * 64 + cc * 2; return st * 1024 + (ob ^ (((ob >> 9) & 1) << 5)); }
__host__ __device__ __forceinline__ void stage_rc(int b, int& R, int& C) { const int st = b / 1024, sb = b % 1024, swz = sb ^ (((sb >> 9) & 1) << 5); R = (st >> 1) * 16 + swz / 64; C = (st & 1) * 32 + (swz % 64) / 2; }
__host__ __device__ __forceinline__ int perm32(int rho) { const int n = rho >> 4, i = rho & 15; return 8 * (i >> 2) + 4 * n + (i & 3); }

struct UD { const char* A; const char* B; unsigned lda, ldb; int pm, pn, seg; };

struct TileOrder {
    int nM, nN, nseg, G, c;
    __device__ __forceinline__ bool tile(int i, int& pm, int& pn, int& seg) const {
        const int ti = i / nseg; seg = i - ti * nseg;
        const long L = (long)ti * G + c; const int nwg = nM * nN; if (L >= nwg) return false;
        int wgid = (int)L; { const int q = nwg / NXCD, r = nwg % NXCD, xcd = wgid % NXCD, off = wgid / NXCD; wgid = (xcd < r ? xcd * (q + 1) : r * (q + 1) + (xcd - r) * q) + off; }
        const int nig = WGM * nN, gid = wgid / nig, fm = gid * WGM, gsz = (nM - fm) < WGM ? (nM - fm) : WGM;
        pm = fm + ((wgid % nig) % gsz); pn = (wgid % nig) / gsz;
        if ((nM & 63) == 0 && (G & 7) == 0) { pn += 4 * (c & 7); pn -= (pn >= nN) ? nN : 0; pn -= (pn >= nN) ? nN : 0; pn -= (pn >= nN) ? nN : 0; pn -= (pn >= nN) ? nN : 0; }
        return true;
    }
};

template <class Epi, class Sched>
__device__ __forceinline__ void gemm_phase(LAS unsigned char* lds, const int tid, const int nt_in, const Sched& S, const Epi& E) {
    int nt = nt_in; asm volatile("" : "+s"(nt));
    const int wid = __builtin_amdgcn_readfirstlane(tid >> 6), lane = tid & 63, wr = wid >> 2, wc = wid & 3, fr = lane & 15, fq = lane >> 4;
    unsigned RA, RB, C2;
    { int R, C; stage_rc(tid * 16, R, C); RA = (unsigned)(Epi::PERMA ? ((R & 64) + 4 * (R & 15) + ((R >> 4) & 3)) : R); RB = (unsigned)((R & ~31) + perm32(R & 31)); C2 = (unsigned)C * 2u; }
    const unsigned ldsw = (unsigned)wid * 1024u;
    const int aoff = lds_byte(wr * 64 + fr, fq * 8), boff = lds_byte(wc * 32 + fr, fq * 8);
#define PG8_SA(b, h) (((b) * 2 + (h)) * HTB)
#define PG8_SB(b, h) ((4 + (b) * 2 + (h)) * HTB)
#define PG8_STAGE(bufoff, gbase, ld, RR) do { const unsigned _vo = RR * (ld) + C2; _Pragma("unroll") for (int _i = 0; _i < 2; ++_i) \
        __builtin_amdgcn_global_load_lds((const unsigned*)((const char*)(gbase) + (size_t)(_i * 64) * (ld) + (size_t)_vo), (LAS unsigned*)(lds + (bufoff) + ldsw + _i * 8192), 16, 0, 0); } while (0)
#define PG8_LDA(dst, b, h) do { _Pragma("unroll") for (int m = 0; m < 4; ++m) _Pragma("unroll") for (int k = 0; k < 2; ++k) dst[m][k] = *(const LAS bf16x8*)(lds + PG8_SA(b, h) + aoff + m * 2048 + k * 1024); } while (0)
#define PG8_LDB(dst, b, h) do { _Pragma("unroll") for (int n = 0; n < 2; ++n) _Pragma("unroll") for (int k = 0; k < 2; ++k) dst[n][k] = *(const LAS bf16x8*)(lds + PG8_SB(b, h) + boff + n * 2048 + k * 1024); } while (0)
#define PG8_MMA(ai, bj, At, Bt) do { __builtin_amdgcn_s_setprio(1); _Pragma("unroll") for (int m = 0; m < 4; ++m) _Pragma("unroll") for (int n = 0; n < 2; ++n) _Pragma("unroll") for (int k = 0; k < 2; ++k) \
        acc[ai][bj][m][n] = __builtin_amdgcn_mfma_f32_16x16x32_bf16(Bt[n][k], At[m][k], acc[ai][bj][m][n], 0, 0, 0); __builtin_amdgcn_s_setprio(0); } while (0)
#define PG8_WAIT_V(n) asm volatile("s_waitcnt vmcnt(" #n ")" ::: "memory")
#define PG8_WAIT_L(n) asm volatile("s_waitcnt lgkmcnt(" #n ")" ::: "memory")
#define PG8_BAR __builtin_amdgcn_s_barrier()
#define PG8_SCHED __builtin_amdgcn_sched_barrier(0)
    UD cur, nxt; int ui = 0;
    if (!S.next(0, cur)) return;
    f32x4 acc[2][2][4][2];
#pragma unroll
    for (int a = 0; a < 2; ++a)
#pragma unroll
        for (int b = 0; b < 2; ++b)
#pragma unroll
            for (int m = 0; m < 4; ++m)
#pragma unroll
                for (int n = 0; n < 2; ++n) acc[a][b][m][n] = (f32x4){0.f, 0.f, 0.f, 0.f};
    bf16x8 At[4][2], B0[2][2], B1[2][2];
    const size_t kstep = (size_t)(BK * 2);
    PG8_STAGE(PG8_SB(0, 0), cur.B, cur.ldb, RB); PG8_STAGE(PG8_SB(0, 1), cur.B + (size_t)HALF * cur.ldb, cur.ldb, RB);
    PG8_STAGE(PG8_SA(0, 0), cur.A, cur.lda, RA); PG8_STAGE(PG8_SA(0, 1), cur.A + (size_t)HALF * cur.lda, cur.lda, RA);
    if (wr == 1) PG8_BAR;
    PG8_WAIT_V(2); PG8_BAR;
    PG8_STAGE(PG8_SB(1, 0), cur.B + kstep, cur.ldb, RB); PG8_STAGE(PG8_SA(1, 0), cur.A + kstep, cur.lda, RA); PG8_STAGE(PG8_SB(1, 1), cur.B + (size_t)HALF * cur.ldb + kstep, cur.ldb, RB);
    PG8_WAIT_V(6); PG8_BAR;
    for (;;) {
        const bool has_next = S.next(ui + 1, nxt);
        if (!has_next) nxt = cur;
        const char* cA = cur.A; const char* cB = cur.B; const unsigned clda = cur.lda, cldb = cur.ldb;
        for (int t = 0; t < nt; t += 2) {
            const bool last = (t == nt - 2);
            const char* a1 = cA + (size_t)(t + 1) * kstep;
            const char* a2 = last ? nxt.A : cA + (size_t)(t + 2) * kstep; const char* b2 = last ? nxt.B : cB + (size_t)(t + 2) * kstep;
            const unsigned lda2 = last ? nxt.lda : clda, ldb2 = last ? nxt.ldb : cldb;
            const char* a3 = a2 + kstep; const char* b3 = b2 + kstep;
            PG8_LDB(B0, 0, 0); PG8_LDB(B1, 0, 1); PG8_SCHED; PG8_LDA(At, 0, 0); PG8_STAGE(PG8_SA(1, 1), a1 + (size_t)HALF * clda, clda, RA);
            PG8_WAIT_V(8); PG8_WAIT_L(0); PG8_BAR; PG8_MMA(0, 0, At, B0); PG8_MMA(0, 1, At, B1); PG8_BAR; PG8_SCHED;
            PG8_LDA(At, 0, 1); PG8_STAGE(PG8_SB(0, 0), b2, ldb2, RB); PG8_STAGE(PG8_SB(0, 1), b2 + (size_t)HALF * ldb2, ldb2, RB); PG8_STAGE(PG8_SA(0, 0), a2, lda2, RA);
            PG8_WAIT_V(8); PG8_WAIT_L(0); PG8_BAR; PG8_MMA(1, 0, At, B0); PG8_MMA(1, 1, At, B1); PG8_BAR; PG8_SCHED;
            PG8_LDB(B0, 1, 0); PG8_LDB(B1, 1, 1); PG8_SCHED; PG8_LDA(At, 1, 0); PG8_STAGE(PG8_SA(0, 1), a2 + (size_t)HALF * lda2, lda2, RA);
            PG8_WAIT_V(8); PG8_WAIT_L(0); PG8_BAR; PG8_MMA(0, 0, At, B0); PG8_MMA(0, 1, At, B1); PG8_BAR; PG8_SCHED;
            PG8_LDA(At, 1, 1); PG8_STAGE(PG8_SB(1, 0), b3, ldb2, RB); PG8_STAGE(PG8_SB(1, 1), b3 + (size_t)HALF * ldb2, ldb2, RB); PG8_STAGE(PG8_SA(1, 0), a3, lda2, RA);
            PG8_WAIT_V(8); PG8_WAIT_L(0); PG8_BAR; PG8_MMA(1, 0, At, B0); PG8_MMA(1, 1, At, B1); PG8_BAR; PG8_SCHED;
        }
        if (wr == 0) PG8_BAR;
        int tt_ = tid; asm volatile("" : "+v"(tt_)); const int fr_ = tt_ & 15, fq_ = (tt_ >> 4) & 3;
        const bool keep = E(acc, cur, wr, wc, fr_, fq_);
        if (!has_next) break;
        if (!keep) {
#pragma unroll
            for (int a = 0; a < 2; ++a)
#pragma unroll
                for (int b = 0; b < 2; ++b)
#pragma unroll
                    for (int m = 0; m < 4; ++m)
#pragma unroll
                        for (int n = 0; n < 2; ++n) acc[a][b][m][n] = (f32x4){0.f, 0.f, 0.f, 0.f};
        }
        cur = nxt; ++ui;
        if (wr == 1) PG8_BAR;
    }
    PG8_WAIT_V(0);
    PG8_BAR;
#undef PG8_SA
#undef PG8_SB
#undef PG8_STAGE
#undef PG8_LDA
#undef PG8_LDB
#undef PG8_MMA
#undef PG8_WAIT_V
#undef PG8_WAIT_L
#undef PG8_BAR
#undef PG8_SCHED
}
}
using pg8::UD;

#define XB_TMO      128
#define XB_XCNT(j)  (256  + 64 * (j))
#define XB_XSUB(j)  (1280 + 64 * (j))
#define XB_XGEN(j)  (2304 + 64 * (j))
#define XB_TOP      3328
#define XB_TOPGEN   3392
#define XCD_BAR_WORDS 3456
#define XB_SPIN_CAP (1u << 21)
__device__ __forceinline__ unsigned xb_ld(unsigned* p)              { return __hip_atomic_load(p, __ATOMIC_RELAXED, __HIP_MEMORY_SCOPE_AGENT); }
__device__ __forceinline__ unsigned xb_add(unsigned* p, unsigned v) { return __hip_atomic_fetch_add(p, v, __ATOMIC_RELAXED, __HIP_MEMORY_SCOPE_AGENT); }
__device__ __forceinline__ unsigned xb_xcc_id() { return (unsigned)__builtin_amdgcn_s_getreg((3 << 11) | 20) & 0xFu; }
#define XB_SPIN(cond, bar) do { unsigned _sp = 0; while (cond) { __builtin_amdgcn_s_sleep(1); \
    if ((++_sp & 255u) == 0u) { if (xb_ld(&(bar)[XB_TMO])) break; if (_sp > XB_SPIN_CAP) { atomicAdd(&(bar)[XB_TMO], 1u); break; } } } } while (0)
struct XcdBarrier { unsigned* bar; unsigned x; volatile LAS unsigned* st; };
__device__ __forceinline__ XcdBarrier xcd_barrier_post(unsigned* bar, volatile LAS unsigned* st, bool leader) {
    XcdBarrier b; b.bar = bar; b.x = xb_xcc_id(); b.st = st;
    if (leader) (void)xb_add(&bar[XB_XCNT(b.x)], 1u);
    return b;
}
__device__ __forceinline__ void xcd_barrier_complete(unsigned* bar, unsigned x, unsigned& nloc, unsigned& nx) {
    const unsigned G = gridDim.x * gridDim.y * gridDim.z;
    unsigned sum, cnt, mine, sp = 0u;
    for (;;) {
        sum = 0u; cnt = 0u; mine = 0u;
#pragma unroll
        for (unsigned j = 0; j < 16; ++j) { const unsigned c = xb_ld(&bar[XB_XCNT(j)]); sum += c; cnt += (c > 0u) ? 1u : 0u; mine = (j == x) ? c : mine; }
        if (sum == G) break;
        __builtin_amdgcn_s_sleep(1);
        if ((++sp & 255u) == 0u) { if (xb_ld(&bar[XB_TMO])) break; if (sp > XB_SPIN_CAP) { atomicAdd(&bar[XB_TMO], 1u); break; } }
    }
    nloc = mine > 0u ? mine : 1u; nx = cnt > 0u ? cnt : 1u;
}
__device__ __forceinline__ void xcd_barrier(const XcdBarrier& b, bool leader) {
    asm volatile("s_waitcnt vmcnt(0)" ::: "memory");
    __syncthreads();
    if (leader) {
        unsigned* bar = b.bar;
        __builtin_amdgcn_s_waitcnt(0);
        unsigned nloc = b.st[0], nx = b.st[1];
        if (nloc == 0u) { xcd_barrier_complete(bar, b.x, nloc, nx); b.st[0] = nloc; b.st[1] = nx; }
        const unsigned old = xb_add(&bar[XB_XSUB(b.x)], 1u);
        const unsigned gen = old / nloc;
        if (old + 1u == (gen + 1u) * nloc) {
            __builtin_amdgcn_fence(__ATOMIC_RELEASE, "agent");
            asm volatile("s_waitcnt vmcnt(0)" ::: "memory");
            const unsigned og = xb_add(&bar[XB_TOP], 1u);
            const unsigned tg = og / nx;
            if (og + 1u == (tg + 1u) * nx) xb_add(&bar[XB_TOPGEN], 1u);
            else XB_SPIN(xb_ld(&bar[XB_TOPGEN]) == tg, bar);
            __builtin_amdgcn_fence(__ATOMIC_ACQUIRE, "agent");
            xb_add(&bar[XB_XGEN(b.x)], 1u);
            asm volatile("s_waitcnt vmcnt(0)" ::: "memory");
        } else {
            XB_SPIN(xb_ld(&bar[XB_XGEN(b.x)]) == gen, bar);
            __builtin_amdgcn_fence(__ATOMIC_ACQUIRE, "agent");
            asm volatile("s_waitcnt vmcnt(0)" ::: "memory");
        }
    }
    __syncthreads();
}

struct Args { const float* in[26]; float* out; unsigned char* ws; int ph_lo, ph_hi; };
struct Frame {
    LAS unsigned char* lds;
    int tid, lane, wave, G, gw, NGW, gtid, NT;
    unsigned char* ws;
};
struct Pass {
    int nseq, L, Mp, rps;
    const bf16_t* H;
    const float* xin; float* xout;
    int vec;
    int rope, is_ctx, batch, full;
};

__device__ __forceinline__ char* slotp(const Frame& F, int s) { return (char*)F.ws + WS_SLOTS + (size_t)s * SLOT; }
__device__ __forceinline__ const float* inp(const Frame& F, int k) {
    const unsigned long long v = ((const LAS unsigned long long*)(F.lds + PTR_OFF))[k];
    const unsigned lo = __builtin_amdgcn_readfirstlane((unsigned)v), hi = __builtin_amdgcn_readfirstlane((unsigned)(v >> 32));
    return (const float*)(GAS const float*)(((unsigned long long)hi << 32) | lo);
}

struct SchedIn { pg8::TileOrder T; const char* H; const char* W; int part;
    __device__ __forceinline__ bool next(int i, UD& u) const { int pm, pn, seg; if (!T.tile(i, pm, pn, seg)) return false;
        const int gl = pn >> 3; const int g = part == 0 ? (gl < 3 ? gl : 4) : (gl == 0 ? 3 : gl + 4);
        u.pm = pm; u.pn = g * 8 + (pn & 7); u.seg = 0;
        u.A = H + (size_t)pm * 256 * 4096; u.B = W + (size_t)u.pn * 256 * 4096; u.lda = 4096u; u.ldb = 4096u; return true; } };
struct EpiIn {
    static constexpr bool PERMA = true;
    char* slots; const float* bias; const float* rope_tab; const float* lg2; const float* stats; const float* gn; const float* cin; int rope; int rps; int Mp;
    __device__ __forceinline__ bool operator()(f32x4 (&acc)[2][2][4][2], const UD& u, int wr, int wc, int fr, int fq) const {
        const int g = u.pn >> 3, hh = u.pn & 7;
        const int row0 = u.pm * 256 + wr * 64 + 4 * fr, col0 = hh * 256 + wc * 32 + 8 * fq, bcol0 = u.pn * 256 + wc * 32 + 8 * fq;
        f32x4 bv[2][2];
#pragma unroll
        for (int bj = 0; bj < 2; ++bj)
#pragma unroll
            for (int n = 0; n < 2; ++n) bv[bj][n] = *(const f32x4*)(bias + bcol0 + bj * 128 + 4 * n);
        if (g < 2) {
            const float sc = (g == 1) ? 0.0625f : 1.0f;
            bf16_t* base = (bf16_t*)(slots + (size_t)g * SLOT);
            const float* cosr = rope_tab; const float* sinr = rope_tab + 256 * 64; const float* cosc = rope_tab + 2 * 256 * 64; const float* sinc = cosc + 64 * 64;
            const int fo = 16 * wc + 4 * fq;
#pragma unroll
            for (int ai = 0; ai < 2; ++ai) {
                f32x4 cr = (f32x4){1.f, 1.f, 1.f, 1.f}, sr = (f32x4){0.f, 0.f, 0.f, 0.f};
                if (rope) { const int trow = ((u.pm * 256 + ai * 128 + wr * 64) % rps) >> 6; cr = *(const f32x4*)(cosr + trow * 64 + fo); sr = *(const f32x4*)(sinr + trow * 64 + fo); }
#pragma unroll
                for (int m = 0; m < 4; ++m) {
                    f32x4 cc = (f32x4){1.f, 1.f, 1.f, 1.f}, sn = (f32x4){0.f, 0.f, 0.f, 0.f};
                    if (rope) { cc = *(const f32x4*)(cosc + (4 * fr + m) * 64 + fo); sn = *(const f32x4*)(sinc + (4 * fr + m) * 64 + fo); }
                    bf16_t* rowp = base + (size_t)(row0 + ai * 128 + m) * DM + col0;
#pragma unroll
                    for (int bj = 0; bj < 2; ++bj) {
                        const f32x4 x1 = acc[ai][bj][m][0] + bv[bj][0], x2 = acc[ai][bj][m][1] + bv[bj][1];
                        const f32x4 c = bj == 0 ? cr : cc, s = bj == 0 ? sr : sn;
                        const f32x4 y1 = (x1 * c - x2 * s) * sc, y2 = (x1 * s + x2 * c) * sc;
                        acc[ai][bj][m][0] = y1; acc[ai][bj][m][1] = y2;
                        u32x4 w; w.x = cvt_pk_bf16(y1[0], y1[1]); w.y = cvt_pk_bf16(y1[2], y1[3]); w.z = cvt_pk_bf16(y2[0], y2[1]); w.w = cvt_pk_bf16(y2[2], y2[3]);
                        ST16(rowp + bj * 128, w);
                    }
                }
            }
            if (g == 1) {
                const float l2f = lg2[hh], l2b = lg2[8 + hh];
                bf16_t* ktf = (bf16_t*)(slots + 2 * SLOT); bf16_t* ktb = (bf16_t*)(slots + 3 * SLOT);
#pragma unroll
                for (int ai = 0; ai < 2; ++ai) {
                    float wf[4], wb[4];
#pragma unroll
                    for (int m = 0; m < 4; ++m) { const int tl = ai * 128 + wr * 64 + 4 * fr + m; wf[m] = __builtin_amdgcn_exp2f(l2f * (float)(255 - tl)); wb[m] = __builtin_amdgcn_exp2f(l2b * (float)tl); }
#pragma unroll
                    for (int bj = 0; bj < 2; ++bj)
#pragma unroll
                        for (int n = 0; n < 2; ++n)
#pragma unroll
                            for (int j = 0; j < 4; ++j) {
                                const size_t o = (size_t)(col0 + bj * 128 + 4 * n + j) * Mp + row0 + ai * 128;
                                const float v0 = acc[ai][bj][0][n][j], v1 = acc[ai][bj][1][n][j], v2 = acc[ai][bj][2][n][j], v3 = acc[ai][bj][3][n][j];
                                u32x2 w; w.x = cvt_pk_bf16(v0 * wf[0], v1 * wf[1]); w.y = cvt_pk_bf16(v2 * wf[2], v3 * wf[3]); *(u32x2*)(ktf + o) = w;
                                w.x = cvt_pk_bf16(v0 * wb[0], v1 * wb[1]); w.y = cvt_pk_bf16(v2 * wb[2], v3 * wb[3]); *(u32x2*)(ktb + o) = w;
                            }
                }
            }
        } else if (g == 2) {
            bf16_t* vt = (bf16_t*)(slots + 4 * SLOT);
#pragma unroll
            for (int ai = 0; ai < 2; ++ai)
#pragma unroll
                for (int bj = 0; bj < 2; ++bj)
#pragma unroll
                    for (int n = 0; n < 2; ++n)
#pragma unroll
                        for (int j = 0; j < 4; ++j) {
                            const size_t o = (size_t)(col0 + bj * 128 + 4 * n + j) * Mp + row0 + ai * 128; const float b = bv[bj][n][j];
                            u32x2 w; w.x = cvt_pk_bf16(acc[ai][bj][0][n][j] + b, acc[ai][bj][1][n][j] + b); w.y = cvt_pk_bf16(acc[ai][bj][2][n][j] + b, acc[ai][bj][3][n][j] + b); *(u32x2*)(vt + o) = w;
                        }
        } else if (g == 3) {
            bf16_t* O = (bf16_t*)(slots + 7 * SLOT);
            f32x4 gv[2][2];
#pragma unroll
            for (int bj = 0; bj < 2; ++bj)
#pragma unroll
                for (int n = 0; n < 2; ++n) gv[bj][n] = *(const f32x4*)(gn + col0 + bj * 128 + 4 * n);
#pragma unroll
            for (int ai = 0; ai < 2; ++ai) {
#pragma unroll
                for (int mp = 0; mp < 2; ++mp) {
                u32x4 ow[2][2]; float mean[2], rstd[2];
#pragma unroll
                for (int mm = 0; mm < 2; ++mm) { const int row = row0 + ai * 128 + 2 * mp + mm;
                    const f32x4 sa = *(const f32x4*)(stats + (size_t)(row * 8 + hh) * 8), sb = *(const f32x4*)(stats + (size_t)(row * 8 + hh) * 8 + 4);
                    ow[mm][0] = *(const u32x4*)(O + (size_t)row * DM + col0); ow[mm][1] = *(const u32x4*)(O + (size_t)row * DM + col0 + 128);
                    const float s1 = (sa.x + sa.z) + (sb.x + sb.z), s2 = (sa.y + sa.w) + (sb.y + sb.w);
                    mean[mm] = s1 * (1.0f / 256.0f); rstd[mm] = 1.0f / sqrtf(fmaxf(s2 * (1.0f / 256.0f) - mean[mm] * mean[mm], 0.f) + EPS); }
#pragma unroll
                for (int mm = 0; mm < 2; ++mm) { const int m = 2 * mp + mm;
                    bf16_t* rowp = O + (size_t)(row0 + ai * 128 + m) * DM + col0;
#pragma unroll
                    for (int bj = 0; bj < 2; ++bj) {
                        const u32x4 w0 = ow[mm][bj];
                        const f32x4 o0 = (f32x4){bf_lo(w0.x), bf_hi(w0.x), bf_lo(w0.y), bf_hi(w0.y)}, o1 = (f32x4){bf_lo(w0.z), bf_hi(w0.z), bf_lo(w0.w), bf_hi(w0.w)};
                        f32x4 v0 = acc[ai][bj][m][0] + bv[bj][0], v1 = acc[ai][bj][m][1] + bv[bj][1];
#pragma unroll
                        for (int j = 0; j < 4; ++j) { v0[j] = fsilu(v0[j]); v1[j] = fsilu(v1[j]); }
                        v0 = v0 * ((o0 - mean[mm]) * rstd[mm] * gv[bj][0]); v1 = v1 * ((o1 - mean[mm]) * rstd[mm] * gv[bj][1]);
                        u32x4 w; w.x = cvt_pk_bf16(v0[0], v0[1]); w.y = cvt_pk_bf16(v0[2], v0[3]); w.z = cvt_pk_bf16(v1[0], v1[1]); w.w = cvt_pk_bf16(v1[2], v1[3]);
                        ST16(rowp + bj * 128, w);
                    }
                }
                }
            }
        } else if (g == 5) {
            bf16_t* HLf = (bf16_t*)(slots + 5 * SLOT); const bf16_t* ACf = (const bf16_t*)(slots + 1 * SLOT); const bf16_t* HLb = (const bf16_t*)(slots + 2 * SLOT); const bf16_t* ACb = (const bf16_t*)(slots + 3 * SLOT);
#pragma unroll
            for (int ai = 0; ai < 2; ++ai) {
                const int blk = u.pm * 4 + ai * 2 + wr;
#pragma unroll
                for (int bj = 0; bj < 2; ++bj) {
                    const float* cfp = cin + (size_t)blk * DM + col0 + bj * 128; const float* cbp = cin + (size_t)(256 + blk) * DM + col0 + bj * 128;
                    const f32x4 cf0 = *(const f32x4*)cfp, cf1 = *(const f32x4*)(cfp + 4), cb0 = *(const f32x4*)cbp, cb1 = *(const f32x4*)(cbp + 4);
#pragma unroll
                    for (int mp = 0; mp < 2; ++mp) {
                    u32x4 hfw[2], afw[2], hbw[2], abw[2];
#pragma unroll
                    for (int mm = 0; mm < 2; ++mm) { const size_t off = (size_t)(row0 + ai * 128 + 2 * mp + mm) * DM + col0 + bj * 128;
                        hfw[mm] = *(const u32x4*)(HLf + off); afw[mm] = *(const u32x4*)(ACf + off); hbw[mm] = *(const u32x4*)(HLb + off); abw[mm] = *(const u32x4*)(ACb + off); }
#pragma unroll
                    for (int mm = 0; mm < 2; ++mm) { const int m = 2 * mp + mm;
                        const size_t off = (size_t)(row0 + ai * 128 + m) * DM + col0 + bj * 128;
                        const u32x4 hf = hfw[mm], af = afw[mm], hb = hbw[mm], ab = abw[mm];
                        f32x4 v0 = acc[ai][bj][m][0] + bv[bj][0], v1 = acc[ai][bj][m][1] + bv[bj][1];
#pragma unroll
                        for (int j = 0; j < 4; ++j) { v0[j] = fgelu(v0[j]); v1[j] = fgelu(v1[j]); }
                        const f32x4 r0 = (f32x4){bf_lo(hf.x) + bf_lo(hb.x), bf_hi(hf.x) + bf_hi(hb.x), bf_lo(hf.y) + bf_lo(hb.y), bf_hi(hf.y) + bf_hi(hb.y)}
                                       + (f32x4){bf_lo(af.x), bf_hi(af.x), bf_lo(af.y), bf_hi(af.y)} * cf0 + (f32x4){bf_lo(ab.x), bf_hi(ab.x), bf_lo(ab.y), bf_hi(ab.y)} * cb0;
                        const f32x4 r1 = (f32x4){bf_lo(hf.z) + bf_lo(hb.z), bf_hi(hf.z) + bf_hi(hb.z), bf_lo(hf.w) + bf_lo(hb.w), bf_hi(hf.w) + bf_hi(hb.w)}
                                       + (f32x4){bf_lo(af.z), bf_hi(af.z), bf_lo(af.w), bf_hi(af.w)} * cf1 + (f32x4){bf_lo(ab.z), bf_hi(ab.z), bf_lo(ab.w), bf_hi(ab.w)} * cb1;
                        v0 = v0 * r0; v1 = v1 * r1;
                        u32x4 w; w.x = cvt_pk_bf16(v0[0], v0[1]); w.y = cvt_pk_bf16(v0[2], v0[3]); w.z = cvt_pk_bf16(v1[0], v1[1]); w.w = cvt_pk_bf16(v1[2], v1[3]);
                        ST16(HLf + off, w);
                    }
                    }
                }
            }
        } else {
            const int slot = g == 4 ? 5 : g + 2;
            bf16_t* base = (bf16_t*)(slots + (size_t)slot * SLOT);
#pragma unroll
            for (int ai = 0; ai < 2; ++ai)
#pragma unroll
                for (int m = 0; m < 4; ++m) {
                    bf16_t* rowp = base + (size_t)(row0 + ai * 128 + m) * DM + col0;
#pragma unroll
                    for (int bj = 0; bj < 2; ++bj) {
                        f32x4 v0 = acc[ai][bj][m][0] + bv[bj][0], v1 = acc[ai][bj][m][1] + bv[bj][1];
                        if (g >= 6) {
#pragma unroll
                            for (int j = 0; j < 4; ++j) { v0[j] = fsigmoid(v0[j]); v1[j] = fsigmoid(v1[j]); }
                        }
                        u32x4 w; w.x = cvt_pk_bf16(v0[0], v0[1]); w.y = cvt_pk_bf16(v0[2], v0[3]); w.z = cvt_pk_bf16(v1[0], v1[1]); w.w = cvt_pk_bf16(v1[2], v1[3]);
                        ST16(rowp + bj * 128, w);
                    }
                }
        }
        return false;
    }
};

struct SchedGate { pg8::TileOrder T; const char* XL; const char* WG;
    __device__ __forceinline__ bool next(int i, UD& u) const { int pm, pn, seg; if (!T.tile(i, pm, pn, seg)) return false; u.pm = pm; u.pn = pn; u.seg = 0;
        const int k = (pn >> 1) & 7; u.A = XL + (size_t)pm * 256 * 4096 + k * 512; u.B = WG + (size_t)pn * 256 * 512; u.lda = 4096u; u.ldb = 512u; return true; } };
template <int CTRL> __device__ __forceinline__ float dpp_f(float idv, float v) { return __int_as_float(__builtin_amdgcn_update_dpp(__float_as_int(idv), __float_as_int(v), CTRL, 0xF, 0xF, false)); }
template <bool BWD> __device__ __forceinline__ void row_scan(float& P, float& H, float& Pe, float& He) {
#define RS_STEP(d) { const float Pn = dpp_f<(BWD ? 0x100 : 0x110) | (d)>(1.0f, P), Hn = dpp_f<(BWD ? 0x100 : 0x110) | (d)>(0.0f, H); H = P * Hn + H; P = P * Pn; }
    RS_STEP(1) RS_STEP(2) RS_STEP(4) RS_STEP(8)
#undef RS_STEP
    Pe = dpp_f<(BWD ? 0x100 : 0x110) | 1>(1.0f, P); He = dpp_f<(BWD ? 0x100 : 0x110) | 1>(0.0f, H);
}
struct EpiGate {
    static constexpr bool PERMA = true;
    const bf16_t* XL; bf16_t* HL0; bf16_t* HL1; bf16_t* AC0; bf16_t* AC1; float* PT; float* HT; const float* ba; const float* bx; const float* cl;
    template <bool BWD> __device__ __forceinline__ void run(f32x4 (&acc)[2][2][4][2], const UD& u, int wr, int wc, int fr, int fq) const {
        const int dir = BWD ? 1 : 0, k = (u.pn >> 1) & 7, half = u.pn & 1;
        const int ch0 = 256 * k + 128 * half + 32 * wc + 8 * fq, row0 = u.pm * 256 + wr * 64 + 4 * fr;
        bf16_t* hl = BWD ? HL1 : HL0; bf16_t* ac = BWD ? AC1 : AC0;
#pragma unroll
        for (int ai = 0; ai < 2; ++ai) {
            u32x4 xw[4];
#pragma unroll
            for (int m = 0; m < 4; ++m) xw[m] = *(const u32x4*)(XL + (size_t)(row0 + ai * 128 + m) * DM + ch0);
            unsigned pkh[2][4][2], pka[2][4][2];
#pragma unroll
            for (int n = 0; n < 2; ++n) {
                const f32x4 bav = *(const f32x4*)(ba + dir * DM + ch0 + 4 * n), bxv = *(const f32x4*)(bx + dir * DM + ch0 + 4 * n), clv = *(const f32x4*)(cl + dir * DM + ch0 + 4 * n);
                f32x4 pt, ht;
#pragma unroll
                for (int jp = 0; jp < 2; ++jp) {
                    float av[4][2], uv[4][2];
#pragma unroll
                    for (int m = 0; m < 4; ++m) {
                        const unsigned xx = n ? (jp ? xw[m].w : xw[m].z) : (jp ? xw[m].y : xw[m].x);
#pragma unroll
                        for (int jj = 0; jj < 2; ++jj) { const int j = 2 * jp + jj;
                            const float r = fsigmoid(acc[ai][0][m][n][j] + bav[j]), ig = fsigmoid(acc[ai][1][m][n][j] + bxv[j]);
                            const float a = __builtin_amdgcn_exp2f(r * clv[j] * 1.44269504089f);
                            av[m][jj] = a; uv[m][jj] = __builtin_amdgcn_sqrtf(fmaxf(1.0f - a * a, 0.f)) * ig * (jj ? bf_hi(xx) : bf_lo(xx)); }
                    }
#pragma unroll
                    for (int jj = 0; jj < 2; ++jj) {
                        float P = 1.0f, H = 0.0f;
#pragma unroll
                        for (int q = 0; q < 4; ++q) { const int m = BWD ? 3 - q : q; H = av[m][jj] * H + uv[m][jj]; P = P * av[m][jj]; uv[m][jj] = H; av[m][jj] = P; }
                        float Pe, He; row_scan<BWD>(P, H, Pe, He);
                        pt[2 * jp + jj] = P; ht[2 * jp + jj] = H;
#pragma unroll
                        for (int m = 0; m < 4; ++m) { uv[m][jj] = uv[m][jj] + av[m][jj] * He; av[m][jj] = av[m][jj] * Pe; }
                    }
#pragma unroll
                    for (int m = 0; m < 4; ++m) { pkh[n][m][jp] = cvt_pk_bf16(uv[m][0], uv[m][1]); pka[n][m][jp] = cvt_pk_bf16(av[m][0], av[m][1]); }
                }
                if (fr == (BWD ? 0 : 15)) { const size_t o = ((size_t)(dir * 256 + u.pm * 4 + ai * 2 + wr)) * DM + ch0 + 4 * n; *(f32x4*)(PT + o) = pt; *(f32x4*)(HT + o) = ht; }
            }
#pragma unroll
            for (int m = 0; m < 4; ++m) {
                const size_t off = (size_t)(row0 + ai * 128 + m) * DM + ch0;
                u32x4 w1, w2; w1.x = pkh[0][m][0]; w1.y = pkh[0][m][1]; w1.z = pkh[1][m][0]; w1.w = pkh[1][m][1]; w2.x = pka[0][m][0]; w2.y = pka[0][m][1]; w2.z = pka[1][m][0]; w2.w = pka[1][m][1];
                *(u32x4*)(hl + off) = w1; *(u32x4*)(ac + off) = w2;
            }
        }
    }
    __device__ __forceinline__ bool operator()(f32x4 (&acc)[2][2][4][2], const UD& u, int wr, int wc, int fr, int fq) const {
        if ((u.pn >> 4) == 0) run<false>(acc, u, wr, wc, fr, fq); else run<true>(acc, u, wr, wc, fr, fq);
        return false;
    }
};

struct SchedAtt { pg8::TileOrder T; const char* Q; const char* K;
    __device__ __forceinline__ bool next(int i, UD& u) const { int pm, pn, seg; if (!T.tile(i, pm, pn, seg)) return false; u.pm = pm; u.pn = pn; u.seg = 0;
        u.A = Q + (size_t)pm * 256 * 4096 + pn * 512; u.B = K + (size_t)pm * 256 * 4096 + pn * 512; u.lda = 4096u; u.ldb = 4096u; return true; } };
struct EpiAtt {
    static constexpr bool PERMA = false;
    bf16_t* P; const float* lg2;
    __device__ __forceinline__ bool operator()(f32x4 (&acc)[2][2][4][2], const UD& u, int wr, int wc, int fr, int fq) const {
        const float l2f = lg2[u.pn], l2b = lg2[8 + u.pn];
        bf16_t* base = P + (size_t)(u.pm * 8 + u.pn) * 65536;
#pragma unroll
        for (int ai = 0; ai < 2; ++ai)
#pragma unroll
            for (int m = 0; m < 4; ++m) {
                const int i = ai * 128 + wr * 64 + m * 16 + fr;
#pragma unroll
                for (int bj = 0; bj < 2; ++bj) {
                    const int j0 = bj * 128 + wc * 32 + 8 * fq;
                    float o[8];
#pragma unroll
                    for (int n = 0; n < 2; ++n)
#pragma unroll
                        for (int j = 0; j < 4; ++j) { const int d = i - (j0 + 4 * n + j);
                            const float w = d > 0 ? __builtin_amdgcn_exp2f(l2f * (float)d) : (d < 0 ? __builtin_amdgcn_exp2f(l2b * (float)(-d)) : 2.0f);
                            o[4 * n + j] = acc[ai][bj][m][n][j] * w; }
                    u32x4 w; w.x = cvt_pk_bf16(o[0], o[1]); w.y = cvt_pk_bf16(o[2], o[3]); w.z = cvt_pk_bf16(o[4], o[5]); w.w = cvt_pk_bf16(o[6], o[7]);
                    *(u32x4*)(base + (size_t)i * 256 + j0) = w;
                }
            }
        return false;
    }
};

struct SchedDS { pg8::TileOrder T; const char* VT; const char* KT0; const char* KT1; unsigned ldT;
    __device__ __forceinline__ bool next(int i, UD& u) const { int pm, pn, seg; if (!T.tile(i, pm, pn, seg)) return false; u.pm = pm; u.pn = pn; u.seg = 0;
        const int dir = pn >> 3, h = pn & 7; u.A = VT + (size_t)h * 256 * ldT + (size_t)pm * 512; u.B = (dir ? KT1 : KT0) + (size_t)h * 256 * ldT + (size_t)pm * 512; u.lda = ldT; u.ldb = ldT; return true; } };
struct EpiDS {
    static constexpr bool PERMA = false;
    bf16_t* S0; bf16_t* S1;
    __device__ __forceinline__ bool operator()(f32x4 (&acc)[2][2][4][2], const UD& u, int wr, int wc, int fr, int fq) const {
        const int dir = u.pn >> 3, h = u.pn & 7;
        bf16_t* base = (dir ? S1 : S0) + (size_t)(u.pm * 8 + h) * 65536;
#pragma unroll
        for (int ai = 0; ai < 2; ++ai)
#pragma unroll
            for (int m = 0; m < 4; ++m) {
                const int i = ai * 128 + wr * 64 + m * 16 + fr;
#pragma unroll
                for (int bj = 0; bj < 2; ++bj) { const f32x4 v0 = acc[ai][bj][m][0], v1 = acc[ai][bj][m][1];
                    u32x4 w; w.x = cvt_pk_bf16(v0[0], v0[1]); w.y = cvt_pk_bf16(v0[2], v0[3]); w.z = cvt_pk_bf16(v1[0], v1[1]); w.w = cvt_pk_bf16(v1[2], v1[3]);
                    *(u32x4*)(base + (size_t)i * 256 + bj * 128 + wc * 32 + 8 * fq) = w; }
            }
        return false;
    }
};

struct SchedOut { pg8::TileOrder T; const char* Q; const char* S0; const char* S1; const char* P; const char* VT; unsigned ldT;
    __device__ __forceinline__ bool next(int i, UD& u) const { int pm, pn, seg; if (!T.tile(i, pm, pn, seg)) return false; u.pm = pm; u.pn = pn; u.seg = seg;
        if (seg < 2) { u.A = Q + (size_t)pm * 256 * 4096 + pn * 512; u.lda = 4096u; u.B = (seg ? S1 : S0) + (size_t)(pm * 8 + pn) * 131072; u.ldb = 512u; }
        else { u.A = P + (size_t)(pm * 8 + pn) * 131072; u.lda = 512u; u.B = VT + (size_t)pn * 256 * ldT + (size_t)pm * 512; u.ldb = ldT; }
        return true; } };
struct EpiOut {
    static constexpr bool PERMA = false;
    bf16_t* O; float* stats; const float* lg2;
    __device__ __forceinline__ bool operator()(f32x4 (&acc)[2][2][4][2], const UD& u, int wr, int wc, int fr, int fq) const {
        const float l2f = lg2[u.pn], l2b = lg2[8 + u.pn];
        if (u.seg < 2) {
#pragma unroll
            for (int ai = 0; ai < 2; ++ai)
#pragma unroll
                for (int m = 0; m < 4; ++m) {
                    const int i = ai * 128 + wr * 64 + m * 16 + fr;
                    const float eb = l2b * (float)(256 - i), ef = l2f * (float)(i + 1);
                    const float s = __builtin_amdgcn_exp2f(u.seg == 0 ? ef - eb : eb);
#pragma unroll
                    for (int bj = 0; bj < 2; ++bj)
#pragma unroll
                        for (int n = 0; n < 2; ++n) acc[ai][bj][m][n] = acc[ai][bj][m][n] * s;
                }
            return true;
        }
#pragma unroll
        for (int ai = 0; ai < 2; ++ai)
#pragma unroll
            for (int m = 0; m < 4; ++m) {
                const int rowg = u.pm * 256 + ai * 128 + wr * 64 + m * 16 + fr;
                float s1 = 0.f, s2 = 0.f;
#pragma unroll
                for (int bj = 0; bj < 2; ++bj) { const f32x4 v0 = acc[ai][bj][m][0], v1 = acc[ai][bj][m][1];
#pragma unroll
                    for (int j = 0; j < 4; ++j) { s1 += v0[j] + v1[j]; s2 += v0[j] * v0[j] + v1[j] * v1[j]; }
                    u32x4 w; w.x = cvt_pk_bf16(v0[0], v0[1]); w.y = cvt_pk_bf16(v0[2], v0[3]); w.z = cvt_pk_bf16(v1[0], v1[1]); w.w = cvt_pk_bf16(v1[2], v1[3]);
                    *(u32x4*)(O + (size_t)rowg * DM + u.pn * 256 + bj * 128 + wc * 32 + 8 * fq) = w; }
                s1 += __shfl_xor(s1, 16); s1 += __shfl_xor(s1, 32); s2 += __shfl_xor(s2, 16); s2 += __shfl_xor(s2, 32);
                if (fq == 0) *(f32x2*)(stats + ((size_t)(rowg * 8 + u.pn) * 4 + wc) * 2) = (f32x2){s1, s2};
            }
        return false;
    }
};

struct SchedMerge { pg8::TileOrder T; const char* YR; const char* YL; const char* WRO; const char* WLO;
    __device__ __forceinline__ bool next(int i, UD& u) const { int pm, pn, seg; if (!T.tile(i, pm, pn, seg)) return false; u.pm = pm; u.pn = pn; u.seg = seg;
        u.A = (seg == 0 ? YR : YL) + (size_t)pm * 256 * 4096; u.B = (seg == 0 ? WRO : WLO) + (size_t)pn * 256 * 4096; u.lda = 4096u; u.ldb = 4096u; return true; } };
struct EpiMerge {
    static constexpr bool PERMA = false;
    const bf16_t* G6; const bf16_t* G7; bf16_t* YM;
    __device__ __forceinline__ bool operator()(f32x4 (&acc)[2][2][4][2], const UD& u, int wr, int wc, int fr, int fq) const {
        const int row0 = u.pm * 256 + wr * 64 + fr, col0 = u.pn * 256 + wc * 32 + 8 * fq;
#pragma unroll
        for (int ai = 0; ai < 2; ++ai)
#pragma unroll
            for (int m = 0; m < 4; ++m)
#pragma unroll
                for (int bj = 0; bj < 2; ++bj) {
                    const size_t off = (size_t)(row0 + ai * 128 + m * 16) * DM + col0 + bj * 128;
                    const u32x4 g7w = *(const u32x4*)(G7 + off);
                    const float g7[8] = {bf_lo(g7w.x), bf_hi(g7w.x), bf_lo(g7w.y), bf_hi(g7w.y), bf_lo(g7w.z), bf_hi(g7w.z), bf_lo(g7w.w), bf_hi(g7w.w)};
                    if (u.seg == 0) {
                        const u32x4 g6w = *(const u32x4*)(G6 + off);
                        const float g6[8] = {bf_lo(g6w.x), bf_hi(g6w.x), bf_lo(g6w.y), bf_hi(g6w.y), bf_lo(g6w.z), bf_hi(g6w.z), bf_lo(g6w.w), bf_hi(g6w.w)};
#pragma unroll
                        for (int n = 0; n < 2; ++n)
#pragma unroll
                            for (int j = 0; j < 4; ++j) acc[ai][bj][m][n][j] *= g6[4 * n + j] * __builtin_amdgcn_rcpf(fmaxf(g7[4 * n + j], 1e-30f));
                    } else {
                        float o[8];
#pragma unroll
                        for (int n = 0; n < 2; ++n)
#pragma unroll
                            for (int j = 0; j < 4; ++j) o[4 * n + j] = acc[ai][bj][m][n][j] * g7[4 * n + j];
                        u32x4 w; w.x = cvt_pk_bf16(o[0], o[1]); w.y = cvt_pk_bf16(o[2], o[3]); w.z = cvt_pk_bf16(o[4], o[5]); w.w = cvt_pk_bf16(o[6], o[7]);
                        ST16(YM + off, w);
                    }
                }
        return u.seg == 0;
    }
};

struct SchedPlain { pg8::TileOrder T; const char* A; const char* B; unsigned lda, ldb;
    __device__ __forceinline__ bool next(int i, UD& u) const { int pm, pn, seg; if (!T.tile(i, pm, pn, seg)) return false; u.pm = pm; u.pn = pn; u.seg = 0;
        u.A = A + (size_t)pm * 256 * lda; u.B = B + (size_t)pn * 256 * ldb; u.lda = lda; u.ldb = ldb; return true; } };
struct EpiPlain {
    static constexpr bool PERMA = false;
    bf16_t* C; int ldc;
    __device__ __forceinline__ bool operator()(f32x4 (&acc)[2][2][4][2], const UD& u, int wr, int wc, int fr, int fq) const {
        const int row0 = u.pm * 256 + wr * 64 + fr, col0 = u.pn * 256 + wc * 32 + 8 * fq;
#pragma unroll
        for (int ai = 0; ai < 2; ++ai)
#pragma unroll
            for (int m = 0; m < 4; ++m)
#pragma unroll
                for (int bj = 0; bj < 2; ++bj) { const f32x4 v0 = acc[ai][bj][m][0], v1 = acc[ai][bj][m][1];
                    u32x4 w; w.x = cvt_pk_bf16(v0[0], v0[1]); w.y = cvt_pk_bf16(v0[2], v0[3]); w.z = cvt_pk_bf16(v1[0], v1[1]); w.w = cvt_pk_bf16(v1[2], v1[3]);
                    ST16(C + (size_t)(row0 + ai * 128 + m * 16) * ldc + col0 + bj * 128, w); }
        return false;
    }
};
struct EpiFfn1 {
    static constexpr bool PERMA = false;
    bf16_t* Fo;
    __device__ __forceinline__ bool operator()(f32x4 (&acc)[2][2][4][2], const UD& u, int wr, int wc, int fr, int fq) const {
        const int row0 = u.pm * 256 + wr * 64 + fr, col0 = u.pn * 128 + wc * 32 + 8 * fq;
#pragma unroll
        for (int ai = 0; ai < 2; ++ai)
#pragma unroll
            for (int m = 0; m < 4; ++m) {
                float o[8];
#pragma unroll
                for (int n = 0; n < 2; ++n)
#pragma unroll
                    for (int j = 0; j < 4; ++j) o[4 * n + j] = fsilu(acc[ai][0][m][n][j]) * acc[ai][1][m][n][j];
                u32x4 w; w.x = cvt_pk_bf16(o[0], o[1]); w.y = cvt_pk_bf16(o[2], o[3]); w.z = cvt_pk_bf16(o[4], o[5]); w.w = cvt_pk_bf16(o[6], o[7]);
                ST16(Fo + (size_t)(row0 + ai * 128 + m * 16) * FFH + col0, w);
            }
        return false;
    }
};

__device__ __forceinline__ int rowmap(int kind, int n) {
    if (kind == 0) { if (n < 4096) { const int f = n & 255; const int p = (f & 128) + 32 * ((f >> 4) & 3) + 8 * ((f >> 2) & 3) + 4 * ((f >> 6) & 1) + (f & 3); return (n & ~255) + p; } return n; }
    if (kind == 2) { const int part = n >= FFH ? 1 : 0, cn = n - part * FFH; return (cn >> 7) * 256 + part * 128 + (cn & 127); }
    if (kind == 3 || kind == 4) { return (n >> 7) * 256 + (kind == 4 ? 128 : 0) + (n & 127); }
    return n;
}
__device__ __forceinline__ void transpose_item(const float* W, int K, int N, bf16_t* WT, int kind, LAS float* scr, int item, int lane) {
    const int nblk = N / 32, kb = item / nblk, nb = item % nblk, k0 = 64 * kb, n0 = 32 * nb;
#pragma unroll 8
    for (int i = 0; i < 32; ++i) { const int kk = 2 * i + (lane >> 5); scr[kk * 33 + (lane & 31)] = W[(size_t)(k0 + kk) * N + n0 + (lane & 31)]; }
    asm volatile("s_waitcnt lgkmcnt(0)" ::: "memory");
    const int c = lane & 7;
#pragma unroll
    for (int j = 0; j < 4; ++j) { const int n = (lane >> 3) + 8 * j; const LAS float* s = scr + (8 * c) * 33 + n;
        u32x4 o; o.x = cvt_pk_bf16(s[0 * 33], s[1 * 33]); o.y = cvt_pk_bf16(s[2 * 33], s[3 * 33]); o.z = cvt_pk_bf16(s[4 * 33], s[5 * 33]); o.w = cvt_pk_bf16(s[6 * 33], s[7 * 33]);
        *(u32x4*)(WT + (size_t)rowmap(kind, n0 + n) * K + k0 + 8 * c) = o; }
    asm volatile("s_waitcnt lgkmcnt(0)" ::: "memory");
}
__device__ __forceinline__ void weights_phase(const Frame& F, int l) {
    LAS float* scr = (LAS float*)(F.lds + F.wave * 16384);
    const float* w_in = inp(F, 10) + (size_t)l * DM * INC; const float* w_ro = inp(F, 21) + (size_t)l * DM * DM; const float* w_lo = inp(F, 22) + (size_t)l * DM * DM; const float* w_out = inp(F, 23) + (size_t)l * DM * DM;
    const float* w_f1 = inp(F, 24) + (size_t)l * DM * 2 * FFH; const float* w_f2 = inp(F, 25) + (size_t)l * FFH * DM;
    const float* wa = inp(F, 16) + (size_t)l * 2 * 8 * 65536; const float* wx = inp(F, 18) + (size_t)l * 2 * 8 * 65536;
    constexpr int I_IN = (DM / 64) * (INC / 32), I_SQ = (DM / 64) * (DM / 32), I_F1 = (DM / 64) * (2 * FFH / 32), I_F2 = (FFH / 64) * (DM / 32), I_G = 4 * 8;
    constexpr int NITEMS = I_IN + 3 * I_SQ + I_F1 + I_F2 + 32 * I_G;
    for (int it = F.gw; it < NITEMS; it += F.NGW) {
        int r = it;
        if (r < I_IN) { transpose_item(w_in, DM, INC, (bf16_t*)(F.ws + WS_WIN), 0, scr, r, F.lane); continue; } r -= I_IN;
        if (r < I_SQ) { transpose_item(w_ro, DM, DM, (bf16_t*)(F.ws + WS_WRO), 1, scr, r, F.lane); continue; } r -= I_SQ;
        if (r < I_SQ) { transpose_item(w_lo, DM, DM, (bf16_t*)(F.ws + WS_WLO), 1, scr, r, F.lane); continue; } r -= I_SQ;
        if (r < I_SQ) { transpose_item(w_out, DM, DM, (bf16_t*)(F.ws + WS_WOUT), 1, scr, r, F.lane); continue; } r -= I_SQ;
        if (r < I_F1) { transpose_item(w_f1, DM, 2 * FFH, (bf16_t*)(F.ws + WS_WF1), 2, scr, r, F.lane); continue; } r -= I_F1;
        if (r < I_F2) { transpose_item(w_f2, FFH, DM, (bf16_t*)(F.ws + WS_WF2), 1, scr, r, F.lane); continue; } r -= I_F2;
        { const int mat = r / I_G, sub = r % I_G;
            const int which = mat >> 4, dk = mat & 15;
            transpose_item((which ? wx : wa) + (size_t)dk * 65536, 256, 256, (bf16_t*)(F.ws + WS_WG) + (size_t)dk * 2 * 256 * 256, which ? 4 : 3, scr, sub, F.lane); }
    }
    float* vec = (float*)(F.ws + WS_VEC);
    const float* b_in = inp(F, 11) + (size_t)l * INC; const float* lam = inp(F, 20) + (size_t)l * 2 * DM; const float* rdec = inp(F, 12) + (size_t)l * 16;
    for (int i = F.gtid; i < INC; i += F.NT) vec[VEC_BINP + rowmap(0, i)] = b_in[i];
    for (int i = F.gtid; i < 2 * DM; i += F.NT) { const float x = -lam[i]; const float sp = x > 15.f ? x : flog1p(fexp(x)); vec[VEC_CL + i] = -8.0f * sp; }
    for (int i = F.gtid; i < 16; i += F.NT) { const float x = rdec[i]; const float ls = x < -15.f ? x : -flog1p(fexp(-x)); vec[VEC_LG2 + i] = ls * 1.44269504089f; }
}
__device__ __forceinline__ void mod_partial_phase(const Frame& F) {
    float* modp = (float*)slotp(F, 10);
    const float* c = inp(F, 1); const float* cctx = inp(F, 3);
    for (int it = blockIdx.x; it < 2 * 6 * 32; it += F.G) {
        const int l = it / 192, nb = (it / 32) % 6, ks = it % 32;
        const float* w = inp(F, 4) + (size_t)l * DM * 12288 + (size_t)(ks * 64) * 12288 + nb * 2048 + F.tid * 4;
        f32x4 s0 = (f32x4){0.f, 0.f, 0.f, 0.f}, s1 = s0, s2 = s0;
#pragma unroll 4
        for (int k = 0; k < 64; ++k) { const f32x4 wv = *(const f32x4*)(w + (size_t)k * 12288); const int kk = ks * 64 + k;
            const float c0 = c[kk], c1 = c[DM + kk], c2 = cctx[kk];
            s0 += wv * fsilu(c0); s1 += wv * fsilu(c1); s2 += wv * fsilu(c2); }
        float* o = modp + ((size_t)(l * 32 + ks) * 3) * 12288 + nb * 2048 + F.tid * 4;
        *(f32x4*)(o) = s0; *(f32x4*)(o + 12288) = s1; *(f32x4*)(o + 2 * 12288) = s2;
    }
}
__device__ __forceinline__ void mod_final_phase(const Frame& F) {
    const float* modp = (const float*)slotp(F, 10); float* cv = (float*)(F.ws + WS_MOD);
    for (int i = F.gtid; i < 2 * 3 * DM; i += F.NT) { const int l = i / (3 * DM), v = (i / DM) % 3, n = i % DM;
        float m[6];
#pragma unroll
        for (int q = 0; q < 6; ++q) { float s = inp(F, 5)[l * 12288 + q * DM + n];
            for (int ks = 0; ks < 32; ++ks) s += modp[((size_t)(l * 32 + ks) * 3 + v) * 12288 + q * DM + n];
            m[q] = s; }
        float* o = cv + (size_t)(l * 3 + v) * 12288 + n;
        o[0] = inp(F, 6)[l * DM + n] * (1.0f + m[1]); o[DM] = m[0]; o[2 * DM] = m[2] * inp(F, 7)[l * DM + n];
        o[3 * DM] = inp(F, 8)[l * DM + n] * (1.0f + m[4]); o[4 * DM] = m[3]; o[5 * DM] = m[5] * inp(F, 9)[l * DM + n]; }
}
__device__ __forceinline__ void tables_phase(const Frame& F) {
    float* tab = (float*)(F.ws + WS_ROPE);
    for (int i = F.gtid; i < 320 * 64; i += F.NT) { const int pos = i >> 6, f = i & 63; const int p = pos < 256 ? pos : pos - 256;
        const float inv = __builtin_amdgcn_exp2f(-(float)f * (13.287712379549449f / 64.0f)); const float ang = (float)p * inv; const float rev = ang * 0.15915494309f; const float s = __builtin_amdgcn_sinf(rev), c = __builtin_amdgcn_cosf(rev);
        if (pos < 256) { tab[pos * 64 + f] = c; tab[256 * 64 + pos * 64 + f] = s; } else { tab[2 * 256 * 64 + p * 64 + f] = c; tab[2 * 256 * 64 + 64 * 64 + p * 64 + f] = s; } }
    const f32x4* src = (const f32x4*)inp(F, 2); f32x4* dst = (f32x4*)(F.ws + WS_CTXS);
    for (int i = F.gtid; i < MCTX * DM / 4; i += F.NT) dst[i] = src[i];
}
__device__ __forceinline__ void rows_phase(const Frame& F, const float* xin, float* xout, const bf16_t* y, bf16_t* hout, int nrows, int rows_per_vec, int vec0,
                                           const float* va  , const float* vb  , const float* vc  ) {
    const int half = rows_per_vec / 2;
    for (int it = F.gw; it < nrows / 2; it += F.NGW) {
        const int blk = it / half, r0 = blk * rows_per_vec + (it - blk * half), r1 = r0 + half;
        const int v = vec0 + blk; const float* pa = va + (size_t)v * 12288; const float* pb = vb + (size_t)v * 12288; const float* pc = vc + (size_t)v * 12288;
        f32x4 x0[8], x1[8];
#pragma unroll
        for (int j = 0; j < 8; ++j) { x0[j] = *(const f32x4*)(xin + (size_t)r0 * DM + (64 * j + F.lane) * 4); x1[j] = *(const f32x4*)(xin + (size_t)r1 * DM + (64 * j + F.lane) * 4); }
        if (y) {
            f32x4 y0[8], y1[8]; float s0 = 0.f, s1 = 0.f;
#pragma unroll
            for (int j = 0; j < 8; ++j) { const u32x2 w0 = *(const u32x2*)(y + (size_t)r0 * DM + (64 * j + F.lane) * 4), w1 = *(const u32x2*)(y + (size_t)r1 * DM + (64 * j + F.lane) * 4);
                y0[j] = (f32x4){bf_lo(w0.x), bf_hi(w0.x), bf_lo(w0.y), bf_hi(w0.y)}; y1[j] = (f32x4){bf_lo(w1.x), bf_hi(w1.x), bf_lo(w1.y), bf_hi(w1.y)};
                s0 += (y0[j].x * y0[j].x + y0[j].y * y0[j].y) + (y0[j].z * y0[j].z + y0[j].w * y0[j].w); s1 += (y1[j].x * y1[j].x + y1[j].y * y1[j].y) + (y1[j].z * y1[j].z + y1[j].w * y1[j].w); }
            const float q0 = 1.0f / sqrtf(wave_sum(s0) * (1.0f / DM) + EPS), q1 = 1.0f / sqrtf(wave_sum(s1) * (1.0f / DM) + EPS);
#pragma unroll
            for (int j = 0; j < 8; ++j) { const int c = (64 * j + F.lane) * 4; const f32x4 a = *(const f32x4*)(pa + c);
                x0[j] = x0[j] + a * (y0[j] * q0); x1[j] = x1[j] + a * (y1[j] * q1);
                *(f32x4*)(xout + (size_t)r0 * DM + c) = x0[j]; *(f32x4*)(xout + (size_t)r1 * DM + c) = x1[j]; }
        }
        if (hout) {
            float s0 = 0.f, s1 = 0.f;
#pragma unroll
            for (int j = 0; j < 8; ++j) { s0 += (x0[j].x * x0[j].x + x0[j].y * x0[j].y) + (x0[j].z * x0[j].z + x0[j].w * x0[j].w); s1 += (x1[j].x * x1[j].x + x1[j].y * x1[j].y) + (x1[j].z * x1[j].z + x1[j].w * x1[j].w); }
            const float q0 = 1.0f / sqrtf(wave_sum(s0) * (1.0f / DM) + EPS), q1 = 1.0f / sqrtf(wave_sum(s1) * (1.0f / DM) + EPS);
#pragma unroll
            for (int j = 0; j < 8; ++j) { const int c = (64 * j + F.lane) * 4; const f32x4 b = *(const f32x4*)(pb + c), sh = *(const f32x4*)(pc + c);
                const f32x4 h0 = (x0[j] * q0) * b + sh, h1 = (x1[j] * q1) * b + sh; u32x2 w0, w1; w0.x = cvt_pk_bf16(h0.x, h0.y); w0.y = cvt_pk_bf16(h0.z, h0.w); w1.x = cvt_pk_bf16(h1.x, h1.y); w1.y = cvt_pk_bf16(h1.z, h1.w);
                *(u32x2*)(hout + (size_t)r0 * DM + c) = w0; *(u32x2*)(hout + (size_t)r1 * DM + c) = w1; }
        }
    }
}
__device__ __forceinline__ void rows_phase_upfront(const Frame& F, const float* xin, float* xout, const bf16_t* y, bf16_t* hout, int nrows, int rows_per_vec, int vec0,
                                           const float* va  , const float* vb  , const float* vc  ) {
    const int half = rows_per_vec / 2;
    for (int it = F.gw; it < nrows / 2; it += F.NGW) {
        const int blk = it / half, r0 = 2 * it, r1 = r0 + 1;
        const int v = vec0 + blk; const float* pa = va + (size_t)v * 12288; const float* pb = vb + (size_t)v * 12288; const float* pc = vc + (size_t)v * 12288;
        const int c0 = F.lane * 4;
        f32x4 x0[8], x1[8]; u32x2 w0[8], w1[8]; f32x4 a[8], b[8], sh[8];
#pragma unroll
        for (int j = 0; j < 8; ++j) { x0[j] = *(const f32x4*)(xin + (size_t)r0 * DM + 256 * j + c0); x1[j] = *(const f32x4*)(xin + (size_t)r1 * DM + 256 * j + c0); }
        if (y) {
#pragma unroll
            for (int j = 0; j < 8; ++j) { w0[j] = *(const u32x2*)(y + (size_t)r0 * DM + 256 * j + c0); w1[j] = *(const u32x2*)(y + (size_t)r1 * DM + 256 * j + c0); }
#pragma unroll
            for (int j = 0; j < 8; ++j) a[j] = *(const f32x4*)(pa + 256 * j + c0);
        }
        if (y) asm volatile("" : "+v"(w0[0]), "+v"(w0[1]), "+v"(w0[2]), "+v"(w0[3]), "+v"(w0[4]), "+v"(w0[5]), "+v"(w0[6]), "+v"(w0[7]), "+v"(w1[0]), "+v"(w1[1]), "+v"(w1[2]), "+v"(w1[3]), "+v"(w1[4]), "+v"(w1[5]), "+v"(w1[6]), "+v"(w1[7]) :: "memory");
        else asm volatile("" ::: "memory");
        if (y) {
            float s0 = 0.f, s1 = 0.f;
#pragma unroll
            for (int j = 0; j < 8; ++j) { const float p0 = bf_lo(w0[j].x), p1 = bf_hi(w0[j].x), p2 = bf_lo(w0[j].y), p3 = bf_hi(w0[j].y), t0 = bf_lo(w1[j].x), t1 = bf_hi(w1[j].x), t2 = bf_lo(w1[j].y), t3 = bf_hi(w1[j].y);
                s0 += (p0 * p0 + p1 * p1) + (p2 * p2 + p3 * p3); s1 += (t0 * t0 + t1 * t1) + (t2 * t2 + t3 * t3); }
            const float q0 = __builtin_amdgcn_rsqf(wave_sum(s0) * (1.0f / DM) + EPS), q1 = __builtin_amdgcn_rsqf(wave_sum(s1) * (1.0f / DM) + EPS);
#pragma unroll
            for (int j = 0; j < 8; ++j) { const int c = 256 * j + c0;
                const f32x4 y0 = (f32x4){bf_lo(w0[j].x), bf_hi(w0[j].x), bf_lo(w0[j].y), bf_hi(w0[j].y)}, y1 = (f32x4){bf_lo(w1[j].x), bf_hi(w1[j].x), bf_lo(w1[j].y), bf_hi(w1[j].y)};
                x0[j] = x0[j] + a[j] * (y0 * q0); x1[j] = x1[j] + a[j] * (y1 * q1);
                *(f32x4*)(xout + (size_t)r0 * DM + c) = x0[j]; *(f32x4*)(xout + (size_t)r1 * DM + c) = x1[j]; }
        }
        if (hout) {
#pragma unroll
            for (int j = 0; j < 8; ++j) { b[j] = *(const f32x4*)(pb + 256 * j + c0); sh[j] = *(const f32x4*)(pc + 256 * j + c0); }
            asm volatile("" ::: "memory");
            float s0 = 0.f, s1 = 0.f;
#pragma unroll
            for (int j = 0; j < 8; ++j) { s0 += (x0[j].x * x0[j].x + x0[j].y * x0[j].y) + (x0[j].z * x0[j].z + x0[j].w * x0[j].w); s1 += (x1[j].x * x1[j].x + x1[j].y * x1[j].y) + (x1[j].z * x1[j].z + x1[j].w * x1[j].w); }
            const float q0 = __builtin_amdgcn_rsqf(wave_sum(s0) * (1.0f / DM) + EPS), q1 = __builtin_amdgcn_rsqf(wave_sum(s1) * (1.0f / DM) + EPS);
#pragma unroll
            for (int j = 0; j < 8; ++j) { const int c = 256 * j + c0;
                const f32x4 h0 = (x0[j] * q0) * b[j] + sh[j], h1 = (x1[j] * q1) * b[j] + sh[j]; u32x2 u0, u1; u0.x = cvt_pk_bf16(h0.x, h0.y); u0.y = cvt_pk_bf16(h0.z, h0.w); u1.x = cvt_pk_bf16(h1.x, h1.y); u1.y = cvt_pk_bf16(h1.z, h1.w);
                *(u32x2*)(hout + (size_t)r0 * DM + c) = u0; *(u32x2*)(hout + (size_t)r1 * DM + c) = u1; }
        }
    }
}
__device__ __forceinline__ void ctx_add_partial(const Frame& F, bf16_t* y0, const bf16_t* y1) {
    for (int it = F.gw; it < MCTX / 2; it += F.NGW) {
#pragma unroll
        for (int h = 0; h < 2; ++h) { const size_t rb = (size_t)(it + h * (MCTX / 2)) * DM;
#pragma unroll
            for (int q = 0; q < 4; ++q) { const size_t off = rb + (size_t)(q * 64 + F.lane) * 8; const u32x4 a = *(const u32x4*)(y0 + off), b = *(const u32x4*)(y1 + off), c2 = *(const u32x4*)(y1 + 2 * MiB + off), d = *(const u32x4*)(y1 + 4 * MiB + off); u32x4 w;
                w.x = cvt_pk_bf16((bf_lo(a.x) + bf_lo(b.x)) + (bf_lo(c2.x) + bf_lo(d.x)), (bf_hi(a.x) + bf_hi(b.x)) + (bf_hi(c2.x) + bf_hi(d.x))); w.y = cvt_pk_bf16((bf_lo(a.y) + bf_lo(b.y)) + (bf_lo(c2.y) + bf_lo(d.y)), (bf_hi(a.y) + bf_hi(b.y)) + (bf_hi(c2.y) + bf_hi(d.y)));
                w.z = cvt_pk_bf16((bf_lo(a.z) + bf_lo(b.z)) + (bf_lo(c2.z) + bf_lo(d.z)), (bf_hi(a.z) + bf_hi(b.z)) + (bf_hi(c2.z) + bf_hi(d.z))); w.w = cvt_pk_bf16((bf_lo(a.w) + bf_lo(b.w)) + (bf_lo(c2.w) + bf_lo(d.w)), (bf_hi(a.w) + bf_hi(b.w)) + (bf_hi(c2.w) + bf_hi(d.w))); *(u32x4*)(y0 + off) = w; } }
    }
    asm volatile("s_waitcnt vmcnt(0)" ::: "memory");
}
__device__ __forceinline__ void conv_phase(const Frame& F, const bf16_t* P4, bf16_t* XL, int Mp, int rps, const float* cw, const float* cb) {
    for (int it = F.gtid; it < (Mp / 8) * 256; it += F.NT) {
        const int rb = it >> 8, cg = it & 255, row0 = rb * 8, t0 = row0 % rps;
        float w[4][8], bias[8];
#pragma unroll
        for (int j = 0; j < 4; ++j) { const f32x4 w0 = *(const f32x4*)(cw + j * DM + cg * 8), w1 = *(const f32x4*)(cw + j * DM + cg * 8 + 4); w[j][0] = w0.x; w[j][1] = w0.y; w[j][2] = w0.z; w[j][3] = w0.w; w[j][4] = w1.x; w[j][5] = w1.y; w[j][6] = w1.z; w[j][7] = w1.w; }
        { const f32x4 b0 = *(const f32x4*)(cb + cg * 8), b1 = *(const f32x4*)(cb + cg * 8 + 4); bias[0] = b0.x; bias[1] = b0.y; bias[2] = b0.z; bias[3] = b0.w; bias[4] = b1.x; bias[5] = b1.y; bias[6] = b1.z; bias[7] = b1.w; }
        u32x4 win[11];
#pragma unroll
        for (int r = 0; r < 11; ++r) { const int tt = t0 + r - 2; win[r] = (tt >= 0 && tt < rps) ? *(const u32x4*)(P4 + (size_t)(row0 + r - 2) * DM + cg * 8) : (u32x4){0u, 0u, 0u, 0u}; }
#pragma unroll
        for (int r = 0; r < 8; ++r) {
            float o[8];
#pragma unroll
            for (int z = 0; z < 8; ++z) o[z] = bias[z];
#pragma unroll
            for (int j = 0; j < 4; ++j) { const u32x4 xw = win[r + j];
                o[0] += bf_lo(xw.x) * w[j][0]; o[1] += bf_hi(xw.x) * w[j][1]; o[2] += bf_lo(xw.y) * w[j][2]; o[3] += bf_hi(xw.y) * w[j][3]; o[4] += bf_lo(xw.z) * w[j][4]; o[5] += bf_hi(xw.z) * w[j][5]; o[6] += bf_lo(xw.w) * w[j][6]; o[7] += bf_hi(xw.w) * w[j][7]; }
            u32x4 wv; wv.x = cvt_pk_bf16(o[0], o[1]); wv.y = cvt_pk_bf16(o[2], o[3]); wv.z = cvt_pk_bf16(o[4], o[5]); wv.w = cvt_pk_bf16(o[6], o[7]);
            *(u32x4*)(XL + (size_t)(row0 + r) * DM + cg * 8) = wv;
        }
    }
}
__device__ __forceinline__ void lru_reduce_phase(const Frame& F, const bf16_t* LAf, const bf16_t* Uf, const bf16_t* LAb, const bf16_t* Ub, int Mp) {
    const int nch = Mp / LCH; float* PS = (float*)(F.ws + WS_PS); float* HE = (float*)(F.ws + WS_HE);
    for (int it = F.gtid; it < 2 * nch * 1024; it += F.NT) {
        const int dir = it / (nch * 1024), c = (it >> 10) % nch, cp = it & 1023;
        const bf16_t* la = (dir ? LAb : LAf) + (size_t)c * LCH * DM + 2 * cp; const bf16_t* uu = (dir ? Ub : Uf) + (size_t)c * LCH * DM + 2 * cp;
        float h0 = 0.f, h1 = 0.f, p0 = 0.f, p1 = 0.f;
#pragma unroll 8
        for (int r = 0; r < LCH; ++r) { const int rr = dir ? LCH - 1 - r : r; const unsigned lw = *(const unsigned*)(la + (size_t)rr * DM), uw = *(const unsigned*)(uu + (size_t)rr * DM);
            const float l0 = bf_lo(lw), l1 = bf_hi(lw); p0 += l0; p1 += l1; h0 = fexp(l0) * h0 + bf_lo(uw); h1 = fexp(l1) * h1 + bf_hi(uw); }
        *(f32x2*)(PS + (size_t)(dir * 128 + c) * DM + 2 * cp) = (f32x2){p0, p1}; *(f32x2*)(HE + (size_t)(dir * 128 + c) * DM + 2 * cp) = (f32x2){h0, h1};
    }
}
__device__ __forceinline__ void lru_final_phase(const Frame& F, const bf16_t* LAf, bf16_t* Uf, const bf16_t* LAb, const bf16_t* Ub, const bf16_t* G5, const Pass& ps) {
    const int nch = ps.Mp / LCH, cps = ps.rps / LCH; const float* PS = (const float*)(F.ws + WS_PS); const float* HE = (const float*)(F.ws + WS_HE); float* HST = (float*)(F.ws + WS_HST);
    for (int it = F.gtid; it < nch * 1024; it += F.NT) {
        const int c = it >> 10, cp = it & 1023, seq = c / cps, cl = c % cps, bidx = ps.is_ctx ? seq : ps.batch;
        float h0 = 0.f, h1 = 0.f;
        if (!ps.is_ctx) { const f32x2 s = *(const f32x2*)(HST + (size_t)(bidx * 2 + 0) * DM + 2 * cp); h0 = s.x; h1 = s.y; }
        for (int cc = seq * cps; cc < c; ++cc) { const f32x2 p = *(const f32x2*)(PS + (size_t)cc * DM + 2 * cp), e = *(const f32x2*)(HE + (size_t)cc * DM + 2 * cp); h0 = fexp(p.x) * h0 + e.x; h1 = fexp(p.y) * h1 + e.y; }
        const size_t base = (size_t)c * LCH * DM + 2 * cp;
#pragma unroll 8
        for (int r = 0; r < LCH; ++r) { const unsigned lw = *(const unsigned*)(LAf + base + (size_t)r * DM), uw = *(const unsigned*)(Uf + base + (size_t)r * DM);
            h0 = fexp(bf_lo(lw)) * h0 + bf_lo(uw); h1 = fexp(bf_hi(lw)) * h1 + bf_hi(uw); *(unsigned*)(Uf + base + (size_t)r * DM) = cvt_pk_bf16(h0, h1); }
        if (ps.is_ctx && cl == cps - 1) *(f32x2*)(HST + (size_t)(bidx * 2 + 0) * DM + 2 * cp) = (f32x2){h0, h1};
        h0 = 0.f; h1 = 0.f;
        if (!ps.is_ctx) { const f32x2 s = *(const f32x2*)(HST + (size_t)(bidx * 2 + 1) * DM + 2 * cp); h0 = s.x; h1 = s.y; }
        for (int cc = seq * cps + cps - 1; cc > c; --cc) { const f32x2 p = *(const f32x2*)(PS + (size_t)(128 + cc) * DM + 2 * cp), e = *(const f32x2*)(HE + (size_t)(128 + cc) * DM + 2 * cp); h0 = fexp(p.x) * h0 + e.x; h1 = fexp(p.y) * h1 + e.y; }
        asm volatile("s_waitcnt vmcnt(0)" ::: "memory");
#pragma unroll 8
        for (int r = LCH - 1; r >= 0; --r) { const unsigned lw = *(const unsigned*)(LAb + base + (size_t)r * DM), uw = *(const unsigned*)(Ub + base + (size_t)r * DM), hw = *(const unsigned*)(Uf + base + (size_t)r * DM), gw = *(const unsigned*)(G5 + base + (size_t)r * DM);
            h0 = fexp(bf_lo(lw)) * h0 + bf_lo(uw); h1 = fexp(bf_hi(lw)) * h1 + bf_hi(uw);
            *(unsigned*)(Uf + base + (size_t)r * DM) = cvt_pk_bf16((h0 + bf_lo(hw)) * bf_lo(gw), (h1 + bf_hi(hw)) * bf_hi(gw)); }
        if (ps.is_ctx && cl == 0) *(f32x2*)(HST + (size_t)(bidx * 2 + 1) * DM + 2 * cp) = (f32x2){h0, h1};
    }
}
__device__ __forceinline__ void lru_carry_phase(const Frame& F, const Pass& ps) {
    float* PT = (float*)(F.ws + WS_PT); float* HT = (float*)(F.ws + WS_HT); float* HST = (float*)(F.ws + WS_HST);
    LAS float* sP = (LAS float*)F.lds; LAS float* sH = sP + 512;
    const int bps = ps.rps / 64, nseg = bps < 16 ? bps : 16, seglen = bps / nseg;
    const int chl = F.tid & 31, seg = F.tid >> 5;
    for (int it = blockIdx.x; it < ps.nseq * 2 * 64; it += F.G) {
        const int cg = it & 63, dir = (it >> 6) & 1, seq = it >> 7, bidx = ps.is_ctx ? seq : ps.batch, ch = cg * 32 + chl;
        float P = 1.0f, H = 0.0f;
        if (seg < nseg) {
#pragma unroll 4
            for (int q = 0; q < seglen; ++q) { const int pos = seg * seglen + q, blk = seq * bps + (dir ? bps - 1 - pos : pos); const size_t o = (size_t)(dir * 256 + blk) * DM + ch;
                const float p = PT[o], e = HT[o]; H = p * H + e; P = P * p; }
        }
        sP[seg * 32 + chl] = P; sH[seg * 32 + chl] = H;
        asm volatile("s_waitcnt lgkmcnt(0)" ::: "memory"); __syncthreads();
        if (seg < nseg) {
            float h = ps.is_ctx ? 0.f : HST[(size_t)(bidx * 2 + dir) * DM + ch];
            for (int s2 = 0; s2 < seg; ++s2) h = sP[s2 * 32 + chl] * h + sH[s2 * 32 + chl];
#pragma unroll 4
            for (int q = 0; q < seglen; ++q) { const int pos = seg * seglen + q, blk = seq * bps + (dir ? bps - 1 - pos : pos); const size_t o = (size_t)(dir * 256 + blk) * DM + ch;
                const float p = PT[o], e = HT[o]; HT[o] = h; h = p * h + e; }
            if (ps.is_ctx && seg == nseg - 1) HST[(size_t)(bidx * 2 + dir) * DM + ch] = h;
        }
        asm volatile("s_waitcnt lgkmcnt(0)" ::: "memory"); __syncthreads();
    }
}
__device__ __forceinline__ void lru_final2_phase(const Frame& F, bf16_t* HLf, const bf16_t* ACf, const bf16_t* HLb, const bf16_t* ACb, const bf16_t* G5, int Mp) {
    const float* CIN = (const float*)(F.ws + WS_HT);
    for (int it = F.gtid; it < Mp * 256; it += F.NT) {
        const int row = it >> 8, cg = it & 255, blk = row >> 6; const size_t off = (size_t)row * DM + cg * 8;
        const u32x4 hf = *(const u32x4*)(HLf + off), af = *(const u32x4*)(ACf + off), hb = *(const u32x4*)(HLb + off), ab = *(const u32x4*)(ACb + off), g = *(const u32x4*)(G5 + off);
        const f32x4 cf0 = *(const f32x4*)(CIN + (size_t)blk * DM + cg * 8), cf1 = *(const f32x4*)(CIN + (size_t)blk * DM + cg * 8 + 4);
        const f32x4 cb0 = *(const f32x4*)(CIN + (size_t)(256 + blk) * DM + cg * 8), cb1 = *(const f32x4*)(CIN + (size_t)(256 + blk) * DM + cg * 8 + 4);
        u32x4 w;
        w.x = cvt_pk_bf16((bf_lo(hf.x) + bf_lo(af.x) * cf0.x + bf_lo(hb.x) + bf_lo(ab.x) * cb0.x) * bf_lo(g.x), (bf_hi(hf.x) + bf_hi(af.x) * cf0.y + bf_hi(hb.x) + bf_hi(ab.x) * cb0.y) * bf_hi(g.x));
        w.y = cvt_pk_bf16((bf_lo(hf.y) + bf_lo(af.y) * cf0.z + bf_lo(hb.y) + bf_lo(ab.y) * cb0.z) * bf_lo(g.y), (bf_hi(hf.y) + bf_hi(af.y) * cf0.w + bf_hi(hb.y) + bf_hi(ab.y) * cb0.w) * bf_hi(g.y));
        w.z = cvt_pk_bf16((bf_lo(hf.z) + bf_lo(af.z) * cf1.x + bf_lo(hb.z) + bf_lo(ab.z) * cb1.x) * bf_lo(g.z), (bf_hi(hf.z) + bf_hi(af.z) * cf1.y + bf_hi(hb.z) + bf_hi(ab.z) * cb1.y) * bf_hi(g.z));
        w.w = cvt_pk_bf16((bf_lo(hf.w) + bf_lo(af.w) * cf1.z + bf_lo(hb.w) + bf_lo(ab.w) * cb1.z) * bf_lo(g.w), (bf_hi(hf.w) + bf_hi(af.w) * cf1.w + bf_hi(hb.w) + bf_hi(ab.w) * cb1.w) * bf_hi(g.w));
        *(u32x4*)(HLf + off) = w;
    }
}
__device__ __forceinline__ void transpose_kv_phase(const Frame& F, const bf16_t* Ksrc, const bf16_t* Vsrc, bf16_t* KTf, bf16_t* KTb, bf16_t* VT, int Mp, const float* lg2) {
    LAS unsigned short* scr = (LAS unsigned short*)(F.lds + F.wave * 16384);
    const int ntt = Mp / 64, nitems = 2 * ntt * 32;
    for (int it = F.gw; it < nitems; it += F.NGW) {
        const int isv = it / (ntt * 32), tt = (it / 32) % ntt, ft = it % 32, tok0 = tt * 64, f0 = ft * 64, h = f0 >> 8;
        const bf16_t* src = isv ? Vsrc : Ksrc;
#pragma unroll
        for (int i = 0; i < 8; ++i) { const int tok = 8 * i + (F.lane >> 3), ch = F.lane & 7; const u32x4 v = *(const u32x4*)(src + (size_t)(tok0 + tok) * DM + f0 + ch * 8);
            LAS unsigned* d = (LAS unsigned*)(scr + tok * 66 + ch * 8); d[0] = v.x; d[1] = v.y; d[2] = v.z; d[3] = v.w; }
        asm volatile("s_waitcnt lgkmcnt(0)" ::: "memory");
        const int q = F.lane & 7; float wf[8], wb[8];
        if (!isv) { const float l2f = lg2[h], l2b = lg2[8 + h];
#pragma unroll
            for (int z = 0; z < 8; ++z) { const int jl = (tok0 + 8 * q + z) & 255; wf[z] = __builtin_amdgcn_exp2f(l2f * (float)(255 - jl)); wb[z] = __builtin_amdgcn_exp2f(l2b * (float)jl); } }
#pragma unroll
        for (int i = 0; i < 8; ++i) { const int f = 8 * i + (F.lane >> 3); float v[8];
#pragma unroll
            for (int z = 0; z < 8; ++z) v[z] = __uint_as_float(((unsigned)scr[(8 * q + z) * 66 + f]) << 16);
            const size_t o = (size_t)(f0 + f) * Mp + tok0 + 8 * q;
            if (isv) { u32x4 w; w.x = cvt_pk_bf16(v[0], v[1]); w.y = cvt_pk_bf16(v[2], v[3]); w.z = cvt_pk_bf16(v[4], v[5]); w.w = cvt_pk_bf16(v[6], v[7]); *(u32x4*)(VT + o) = w; }
            else { u32x4 w; w.x = cvt_pk_bf16(v[0] * wf[0], v[1] * wf[1]); w.y = cvt_pk_bf16(v[2] * wf[2], v[3] * wf[3]); w.z = cvt_pk_bf16(v[4] * wf[4], v[5] * wf[5]); w.w = cvt_pk_bf16(v[6] * wf[6], v[7] * wf[7]); *(u32x4*)(KTf + o) = w;
                w.x = cvt_pk_bf16(v[0] * wb[0], v[1] * wb[1]); w.y = cvt_pk_bf16(v[2] * wb[2], v[3] * wb[3]); w.z = cvt_pk_bf16(v[4] * wb[4], v[5] * wb[5]); w.w = cvt_pk_bf16(v[6] * wb[6], v[7] * wb[7]); *(u32x4*)(KTb + o) = w; } }
        asm volatile("s_waitcnt lgkmcnt(0)" ::: "memory");
    }
}
__device__ __forceinline__ void state_scan_phase(const Frame& F, bf16_t* Sf, bf16_t* Sb, const Pass& ps, const float* lg2) {
    float* SST = (float*)(F.ws + WS_SST);
    for (int it = F.gtid; it < 2 * 8 * 256 * 32; it += F.NT) {
        const int dir = it >> 16, h = (it >> 13) & 7, e = (it >> 5) & 255, d8 = (it & 31) * 8;
        const float g = __builtin_amdgcn_exp2f(256.0f * lg2[dir * 8 + h]);
        bf16_t* Sd = dir ? Sb : Sf;
        for (int seq = 0; seq < ps.nseq; ++seq) {
            const int bidx = ps.is_ctx ? seq : ps.batch;
            float* sst = SST + ((size_t)((bidx * 2 + dir) * 8 + h) * 256 + e) * 256 + d8;
            float s[8];
            if (ps.is_ctx) {
#pragma unroll
                for (int z = 0; z < 8; ++z) s[z] = 0.f;
            } else { const f32x4 a = *(const f32x4*)sst, b = *(const f32x4*)(sst + 4); s[0] = a.x; s[1] = a.y; s[2] = a.z; s[3] = a.w; s[4] = b.x; s[5] = b.y; s[6] = b.z; s[7] = b.w; }
            for (int k0 = 0; k0 < ps.L; k0 += 8) {
                u32x4 w8[8];
#pragma unroll
                for (int i = 0; i < 8; ++i) { const int k = k0 + i; if (k < ps.L) { const int cc = seq * ps.L + (dir ? ps.L - 1 - k : k); w8[i] = *(const u32x4*)(Sd + ((size_t)(cc * 8 + h) * 256 + e) * 256 + d8); } else w8[i] = (u32x4){0u, 0u, 0u, 0u}; }
#pragma unroll
                for (int i = 0; i < 8; ++i) { const int k = k0 + i; if (k < ps.L) { const int cc = seq * ps.L + (dir ? ps.L - 1 - k : k);
                    bf16_t* p = Sd + ((size_t)(cc * 8 + h) * 256 + e) * 256 + d8; const u32x4 w = w8[i];
                    u32x4 o; o.x = cvt_pk_bf16(s[0], s[1]); o.y = cvt_pk_bf16(s[2], s[3]); o.z = cvt_pk_bf16(s[4], s[5]); o.w = cvt_pk_bf16(s[6], s[7]); *(u32x4*)p = o;
                    s[0] = g * s[0] + bf_lo(w.x); s[1] = g * s[1] + bf_hi(w.x); s[2] = g * s[2] + bf_lo(w.y); s[3] = g * s[3] + bf_hi(w.y); s[4] = g * s[4] + bf_lo(w.z); s[5] = g * s[5] + bf_hi(w.z); s[6] = g * s[6] + bf_lo(w.w); s[7] = g * s[7] + bf_hi(w.w); } }
            }
            if (ps.is_ctx) { *(f32x4*)sst = (f32x4){s[0], s[1], s[2], s[3]}; *(f32x4*)(sst + 4) = (f32x4){s[4], s[5], s[6], s[7]}; }
        }
    }
}
__device__ __forceinline__ void yr_phase(const Frame& F, bf16_t* O, const bf16_t* G3, const float* stats, const float* gn, int Mp) {
    for (int it = F.gtid; it < Mp * 256; it += F.NT) {
        const int row = it >> 8, cg = it & 255, h = cg >> 5;
        const f32x4 a = *(const f32x4*)(stats + (size_t)(row * 8 + h) * 8), b = *(const f32x4*)(stats + (size_t)(row * 8 + h) * 8 + 4);
        const float s1 = (a.x + a.z) + (b.x + b.z), s2 = (a.y + a.w) + (b.y + b.w);
        const float mean = s1 * (1.0f / 256.0f), var = fmaxf(s2 * (1.0f / 256.0f) - mean * mean, 0.f), rstd = 1.0f / sqrtf(var + EPS);
        const size_t off = (size_t)row * DM + cg * 8; const u32x4 ow = *(const u32x4*)(O + off), gw = *(const u32x4*)(G3 + off);
        const f32x4 g0 = *(const f32x4*)(gn + cg * 8), g1 = *(const f32x4*)(gn + cg * 8 + 4);
        u32x4 w; w.x = cvt_pk_bf16(bf_lo(gw.x) * (bf_lo(ow.x) - mean) * rstd * g0.x, bf_hi(gw.x) * (bf_hi(ow.x) - mean) * rstd * g0.y);
        w.y = cvt_pk_bf16(bf_lo(gw.y) * (bf_lo(ow.y) - mean) * rstd * g0.z, bf_hi(gw.y) * (bf_hi(ow.y) - mean) * rstd * g0.w);
        w.z = cvt_pk_bf16(bf_lo(gw.z) * (bf_lo(ow.z) - mean) * rstd * g1.x, bf_hi(gw.z) * (bf_hi(ow.z) - mean) * rstd * g1.y);
        w.w = cvt_pk_bf16(bf_lo(gw.w) * (bf_lo(ow.w) - mean) * rstd * g1.z, bf_hi(gw.w) * (bf_hi(ow.w) - mean) * rstd * g1.w);
        *(u32x4*)(O + off) = w;
    }
}

#define OPQ_S(x) do { (x) = __builtin_amdgcn_readfirstlane(x); asm volatile("" : "+s"(x)); } while (0)
#define OPQ_S64(x) do { unsigned lo__ = __builtin_amdgcn_readfirstlane((unsigned)(x)), hi__ = __builtin_amdgcn_readfirstlane((unsigned)((x) >> 32)); asm volatile("" : "+s"(lo__), "+s"(hi__)); (x) = ((unsigned long long)hi__ << 32) | lo__; } while (0)
__device__ __forceinline__ void make_pass(const Frame& F, const Args& args, int l, int pi, Pass& ps) {
    if (pi == 0) { ps.nseq = 2; ps.L = 1; ps.Mp = MCTX; ps.rps = CTXL; ps.H = (const bf16_t*)(F.ws + WS_HCTX); ps.xin = (const float*)(F.ws + WS_CTXS); ps.xout = (float*)(F.ws + WS_CTXS);
        ps.vec = 2; ps.rope = 0; ps.is_ctx = 1; ps.batch = 0; ps.full = (l + 1 < DEPTH); }
    else { const int b = pi - 1; ps.nseq = 1; ps.L = SEQ / 256; ps.Mp = SEQ; ps.rps = SEQ; ps.H = (const bf16_t*)(F.ws + WS_HLAT) + (size_t)b * SEQ * DM;
        ps.xin = (l == 0 ? inp(F, 0) : (const float*)args.out) + (size_t)b * SEQ * DM; ps.xout = args.out + (size_t)b * SEQ * DM; ps.vec = b; ps.rope = 1; ps.is_ctx = 0; ps.batch = b; ps.full = 1; }
}
#ifndef PH_MASK
#define PH_MASK 0xffffffffu
#endif
#define PHON(k) ((PH_MASK >> (k)) & 1u)
#ifndef DUP_MASK
#define DUP_MASK 0u
#endif
#define NREP(k) (((DUP_MASK >> (k)) & 1u) ? 2 : 1)
__global__ void __launch_bounds__(512, 2) mk_fwd(Args args) {
    extern __shared__ __attribute__((aligned(16))) unsigned char lds_raw[];
    {
        const int tid0 = threadIdx.x;
        for (int u = tid0; u < (LDS_BYTES - LDSCTL_OFF) / 4; u += 512) ((LAS unsigned*)((LAS unsigned char*)lds_raw + LDSCTL_OFF))[u] = 0u;
        __syncthreads();
        if (tid0 == 0) {
            LAS unsigned long long* tab = (LAS unsigned long long*)((LAS unsigned char*)lds_raw + PTR_OFF);
#pragma unroll
            for (int k = 0; k < 26; ++k) tab[k] = (unsigned long long)args.in[k];
        }
        __syncthreads();
    }
    const int lo = args.ph_lo, hi = args.ph_hi;
    const int wave0 = __builtin_amdgcn_readfirstlane((int)threadIdx.x >> 6);
#define LANE_ID() ({ int l__; asm volatile("v_mbcnt_lo_u32_b32 %0, -1, 0\n\tv_mbcnt_hi_u32_b32 %0, -1, %0" : "=v"(l__)); l__; })
    if (hi - lo > 1) (void)xcd_barrier_post((unsigned*)(args.ws + WS_CTL) + CW_BAR, (volatile LAS unsigned*)((LAS unsigned char*)lds_raw + MISC_OFF) + 8, threadIdx.x == 0);
    int pc = 0;
#define RUN (pc >= lo && pc < hi)
#define ENDPH do { if (RUN && pc + 1 < hi) { XcdBarrier b_; b_.bar = (unsigned*)(args.ws + WS_CTL) + CW_BAR; b_.x = xb_xcc_id(); b_.st = (volatile LAS unsigned*)((LAS unsigned char*)lds_raw + MISC_OFF) + 8; xcd_barrier(b_, wave0 == 0 && LANE_ID() == 0); } ++pc; } while (0)
#define LOCALS Frame F; { int tid_ = wave0 * 64 + LANE_ID(); asm volatile("" : "+v"(tid_)); unsigned long long ws_ = (unsigned long long)args.ws; OPQ_S64(ws_); F.lds = (LAS unsigned char*)lds_raw; F.tid = tid_; F.lane = tid_ & 63; F.wave = wave0; \
        F.G = gridDim.x; F.gw = blockIdx.x * 8 + F.wave; F.NGW = F.G * 8; F.gtid = blockIdx.x * 512 + tid_; F.NT = F.G * 512; F.ws = (unsigned char*)(GAS unsigned char*)ws_; } int l_ = l; OPQ_S(l_); const int c = (int)blockIdx.x; float* mod = (float*)(F.ws + WS_MOD); const float* vec = (const float*)(F.ws + WS_VEC); const float* modl = mod + (size_t)l_ * 3 * 12288; (void)vec; (void)modl; (void)c
#define PASSLOCALS LOCALS; int pi_ = pi; OPQ_S(pi_); Pass ps; make_pass(F, args, l_, pi_, ps); const int nM = ps.Mp / 256; const unsigned ldT = (unsigned)ps.Mp * 2u; (void)nM; (void)ldT
#define SL(k) ((bf16_t*)slotp(F, (k)))

    { const int l = 0; if (RUN) { if (PHON(0)) for (int rep_ = 0; rep_ < NREP(0); ++rep_) { LOCALS; mod_partial_phase(F); tables_phase(F); } } ENDPH;
    if (RUN) { if (PHON(0)) for (int rep_ = 0; rep_ < NREP(0); ++rep_) { LOCALS; mod_final_phase(F); } } ENDPH; }

    for (int lx = 0; lx <= DEPTH; ++lx) {
        if (RUN) {
            if (lx > 0) { const int l = lx - 1; if (PHON(19)) { LOCALS;
                const bool more = (l_ + 1 < DEPTH); const float* modn = mod + (size_t)(more ? l_ + 1 : l_) * 3 * 12288;
                rows_phase(F, args.out, args.out, (const bf16_t*)slotp(F, 6), more ? (bf16_t*)(F.ws + WS_HLAT) : nullptr, MLAT, SEQ, 0, modl + 5 * DM, modn, modn + DM);
                if (more) { ctx_add_partial(F, (bf16_t*)slotp(F, 9), (const bf16_t*)slotp(F, 10)); }
                if (more) rows_phase(F, (const float*)(F.ws + WS_CTXS), (float*)(F.ws + WS_CTXS), (const bf16_t*)slotp(F, 9), (bf16_t*)(F.ws + WS_HCTX), MCTX, MCTX, 2, modl + 5 * DM, modn, modn + DM); } }
            if (lx < DEPTH) { const int l = lx; if (PHON(1)) for (int rep_ = 0; rep_ < NREP(1); ++rep_) { LOCALS;
                weights_phase(F, l_);
                if (l_ == 0) {
                    rows_phase(F, inp(F, 0), nullptr, nullptr, (bf16_t*)(F.ws + WS_HLAT), MLAT, SEQ, 0, modl, modl, modl + DM);
                    rows_phase(F, inp(F, 2), nullptr, nullptr, (bf16_t*)(F.ws + WS_HCTX), MCTX, MCTX, 2, modl, modl, modl + DM);
                } } }
        } ENDPH;
        if (lx == DEPTH) break;
        const int l = lx;

        for (int px = 0; px <= 3; ++px) {
            if (RUN) { for (int step_ = 0; step_ < 2; ++step_) { const bool thin_ = ((step_ ^ (int)(blockIdx.x >> 3)) & 1) == 0;
                if (thin_) { if (px > 0) { const int pi = px - 1; if (PHON(16)) { PASSLOCALS; if (ps.full) rows_phase_upfront(F, ps.xin, ps.xout, SL(10), (bf16_t*)ps.H, ps.Mp, ps.Mp, ps.vec, modl + 2 * DM, modl + 3 * DM, modl + 4 * DM); } } }
                else { if (px < 3) { const int pi = px; if (PHON(2)) for (int rep_ = 0; rep_ < NREP(2); ++rep_) { PASSLOCALS; SchedIn S{{nM, 32, 1, F.G, c}, (const char*)ps.H, (const char*)(F.ws + WS_WIN), 0};
                    EpiIn E{slotp(F, 0), vec + VEC_BINP, (const float*)(F.ws + WS_ROPE), vec + VEC_LG2, (const float*)(F.ws + WS_STATS), inp(F, 13) + l_ * DM, (const float*)(F.ws + WS_HT), ps.rope, ps.rps, ps.Mp};
                    pg8::gemm_phase(F.lds, F.tid, 32, S, E); } } }
            } } ENDPH;
            if (px == 3) break;
            const int pi = px;
            if (RUN) { for (int step_ = 0; step_ < 2; ++step_) { const bool thin_ = ((step_ ^ (int)(blockIdx.x >> 3)) & 1) == 0;
                if (thin_) { if (PHON(3)) for (int rep_ = 0; rep_ < NREP(3); ++rep_) { PASSLOCALS; conv_phase(F, SL(5), SL(7), ps.Mp, ps.rps, inp(F, 14) + l_ * 4 * DM, inp(F, 15) + l_ * DM); } }
                else {
                if (PHON(8)) for (int rep_ = 0; rep_ < NREP(8); ++rep_) { PASSLOCALS; SchedAtt S{{nM, 8, 1, F.G, c}, (const char*)SL(0), (const char*)SL(1)}; EpiAtt E{SL(8), vec + VEC_LG2}; pg8::gemm_phase(F.lds, F.tid, 4, S, E); }
                if (PHON(9)) for (int rep_ = 0; rep_ < NREP(9); ++rep_) { PASSLOCALS; SchedDS S{{nM, 16, 1, F.G, c}, (const char*)SL(4), (const char*)SL(2), (const char*)SL(3), ldT}; EpiDS E{SL(9), SL(10)}; pg8::gemm_phase(F.lds, F.tid, 4, S, E); }
                } } } ENDPH;
            if (RUN) { for (int step_ = 0; step_ < 2; ++step_) { const bool thin_ = ((step_ ^ (int)(blockIdx.x >> 3)) & 1) == 0;
                if (thin_) { if (PHON(10)) { PASSLOCALS; state_scan_phase(F, SL(9), SL(10), ps, vec + VEC_LG2); } }
                else { if (PHON(4)) for (int rep_ = 0; rep_ < NREP(4); ++rep_) { PASSLOCALS; SchedGate S{{nM, 32, 1, F.G, c}, (const char*)SL(7), (const char*)(F.ws + WS_WG)};
                    EpiGate E{SL(7), SL(5), SL(2), SL(1), SL(3), (float*)(F.ws + WS_PT), (float*)(F.ws + WS_HT), inp(F, 17) + l_ * 2 * DM, inp(F, 19) + l_ * 2 * DM, vec + VEC_CL};
                    pg8::gemm_phase(F.lds, F.tid, 4, S, E); } }
            } } ENDPH;
            if (RUN) {
                if (PHON(5)) { PASSLOCALS; lru_carry_phase(F, ps); }
                if (PHON(11)) for (int rep_ = 0; rep_ < NREP(11); ++rep_) { PASSLOCALS; if (ps.full) { SchedOut S{{nM, 8, 3, F.G, c}, (const char*)SL(0), (const char*)SL(9), (const char*)SL(10), (const char*)SL(8), (const char*)SL(4), ldT}; EpiOut E{SL(7), (float*)(F.ws + WS_STATS), vec + VEC_LG2}; pg8::gemm_phase(F.lds, F.tid, 4, S, E); } }
            } ENDPH;
            if (RUN) {
                if (PHON(12)) { PASSLOCALS; if (ps.full) { SchedIn S{{nM, 32, 1, F.G, c}, (const char*)ps.H, (const char*)(F.ws + WS_WIN), 1};
                    EpiIn E{slotp(F, 0), vec + VEC_BINP, (const float*)(F.ws + WS_ROPE), vec + VEC_LG2, (const float*)(F.ws + WS_STATS), inp(F, 13) + l_ * DM, (const float*)(F.ws + WS_HT), 0, ps.rps, ps.Mp};
                    pg8::gemm_phase(F.lds, F.tid, 32, S, E); } }
            } ENDPH;
            if (RUN) { if (PHON(14)) for (int rep_ = 0; rep_ < NREP(14); ++rep_) { PASSLOCALS; if (ps.full) { SchedMerge S{{nM, 8, 2, F.G, c}, (const char*)SL(7), (const char*)SL(5), (const char*)(F.ws + WS_WRO), (const char*)(F.ws + WS_WLO)}; EpiMerge E{SL(8), SL(9), SL(0)};
                pg8::gemm_phase(F.lds, F.tid, 32, S, E); } } } ENDPH;
            if (RUN) { if (PHON(15)) for (int rep_ = 0; rep_ < NREP(15); ++rep_) { PASSLOCALS; if (ps.full) { SchedPlain S{{nM, 8, 1, F.G, c}, (const char*)SL(0), (const char*)(F.ws + WS_WOUT), 4096u, 4096u}; EpiPlain E{SL(10), DM}; pg8::gemm_phase(F.lds, F.tid, 32, S, E); } } } ENDPH;
        }
        if (RUN) { if (PHON(17)) for (int rep_ = 0; rep_ < NREP(17); ++rep_) { LOCALS; const int nparts = (l_ + 1 < DEPTH) ? 2 : 1; for (int part = 0; part < nparts; ++part) {
            const char* Hp = part ? (const char*)(F.ws + WS_HCTX) : (const char*)(F.ws + WS_HLAT); const int nM = part ? MCTX / 256 : MLAT / 256;
            SchedPlain S{{nM, 44, 1, F.G, c}, Hp, (const char*)(F.ws + WS_WF1), 4096u, 4096u}; EpiFfn1 E{(bf16_t*)slotp(F, part ? 8 : 0)}; pg8::gemm_phase(F.lds, F.tid, 32, S, E); } } } ENDPH;
        if (RUN) { if (PHON(18)) for (int rep_ = 0; rep_ < NREP(18); ++rep_) { LOCALS; const int nparts = (l_ + 1 < DEPTH) ? 5 : 1; for (int part = 0; part < nparts; ++part) {
            const int nM = part ? MCTX / 256 : MLAT / 256, kh = part ? part - 1 : 0; const int cc = (F.G >= 64) ? (c + F.G - 16 * kh) % F.G : c;
            SchedPlain S{{nM, 8, 1, F.G, cc}, (const char*)slotp(F, part ? 8 : 0) + (size_t)kh * 22 * 128, (const char*)(F.ws + WS_WF2) + (size_t)kh * 22 * 128, (unsigned)FFH * 2u, (unsigned)FFH * 2u};
            EpiPlain E{part == 0 ? (bf16_t*)slotp(F, 6) : kh == 0 ? (bf16_t*)slotp(F, 9) : (bf16_t*)(slotp(F, 10) + (size_t)(kh - 1) * 4 * MiB), DM}; pg8::gemm_phase(F.lds, F.tid, part ? 22 : 88, S, E); } } } ENDPH;
    }
#undef RUN
#undef ENDPH
}

extern "C" void kernel_launch(void* const* d_in, const int* in_sizes, int n_in, void* d_out, int out_size, void* d_ws, size_t ws_size, hipStream_t stream) {
    static int grid = 0;
    if (grid == 0) {
        if (n_in != 26 || ws_size < WS_END) { fprintf(stderr, "kernel_launch: need 26 inputs and >= %zu bytes of workspace (got %d, %zu)\n", (size_t)WS_END, n_in, ws_size); grid = -1; return; }
        int dev = 0, cus = 0, per_cu = 0;
        if (hipGetDevice(&dev) != hipSuccess || hipDeviceGetAttribute(&cus, hipDeviceAttributeMultiprocessorCount, dev) != hipSuccess) { grid = -1; return; }
        if (hipFuncSetAttribute((const void*)mk_fwd, hipFuncAttributeMaxDynamicSharedMemorySize, LDS_BYTES) != hipSuccess) { fprintf(stderr, "kernel_launch: hipFuncSetAttribute failed\n"); grid = -1; return; }
        if (hipOccupancyMaxActiveBlocksPerMultiprocessor(&per_cu, (const void*)mk_fwd, 512, LDS_BYTES) != hipSuccess || per_cu < 1) fprintf(stderr, "kernel_launch: occupancy query reports %d\n", per_cu);
        (void)hipGetLastError();
        grid = cus;
    }
    if (grid < 0) return;
    (void)hipMemsetAsync((char*)d_ws + WS_CTL, 0, CTL_ZERO_BYTES, stream);
    Args a{};
    for (int i = 0; i < 26; ++i) a.in[i] = (const float*)d_in[i];
    a.out = (float*)d_out; a.ws = (unsigned char*)d_ws;
#if MK_PER_PHASE
    for (int k = 0; k < 128; ++k) { a.ph_lo = k; a.ph_hi = k + 1; hipLaunchKernelGGL(mk_fwd, dim3(grid), dim3(512), LDS_BYTES, stream, a); }
#else
    a.ph_lo = 0; a.ph_hi = 1 << 20;
    hipLaunchKernelGGL(mk_fwd, dim3(grid), dim3(512), LDS_BYTES, stream, a);
#endif
}
```

```cpp
#include <hip/hip_runtime.h>
#include <cstdio>
#include <cstdint>

#ifndef MK_PER_PHASE
#define MK_PER_PHASE 0
#endif

#define LAS __attribute__((address_space(3)))
#define GAS __attribute__((address_space(1)))
typedef unsigned short bf16_t;
typedef short bf16x8 __attribute__((ext_vector_type(8)));
typedef float f32x4 __attribute__((ext_vector_type(4)));
typedef float f32x2 __attribute__((ext_vector_type(2)));
typedef unsigned u32x4 __attribute__((ext_vector_type(4)));
typedef unsigned u32x2 __attribute__((ext_vector_type(2)));

constexpr int DM = 2048, NBATCH = 2, SEQ = 16384, CTXL = 256, DEPTH = 2, NH = 8, HD = 256, FFH = 5632, INC = 16384;
constexpr int MLAT = NBATCH * SEQ, MCTX = NBATCH * CTXL;
constexpr int LCH = 128;
constexpr float EPS = 1e-6f;
constexpr size_t MiB = 1u << 20;
constexpr size_t WS_CTL = 0, CTL_ZERO_BYTES = 1 * MiB;
constexpr size_t WS_MOD = 1 * MiB;
constexpr size_t WS_ROPE = 2 * MiB;
constexpr size_t WS_PS = 3 * MiB, WS_HE = 5 * MiB;
constexpr size_t WS_HST = 7 * MiB;
constexpr size_t WS_STATS = 8 * MiB;
constexpr size_t WS_SST = 12 * MiB;
constexpr size_t WS_CTXS = 20 * MiB;
constexpr size_t WS_HCTX = 24 * MiB;
constexpr size_t WS_VEC = 26 * MiB;
constexpr size_t WS_PT = 28 * MiB, WS_HT = 32 * MiB;
constexpr size_t WS_WIN = 36 * MiB;
constexpr size_t WS_WRO = WS_WIN + 64 * MiB, WS_WLO = WS_WRO + 8 * MiB, WS_WOUT = WS_WLO + 8 * MiB;
constexpr size_t WS_WG = WS_WOUT + 8 * MiB;
constexpr size_t WS_WF1 = WS_WG + 4 * MiB;
constexpr size_t WS_WF2 = WS_WF1 + 44 * MiB;
constexpr size_t WS_HLAT = WS_WF2 + 22 * MiB;
constexpr size_t WS_SLOTS = WS_HLAT + 128 * MiB;
constexpr size_t SLOT = 64 * MiB;
constexpr int NSLOT = 11;
constexpr size_t WS_END = WS_SLOTS + NSLOT * SLOT;
static_assert(WS_WF2 + 22 * MiB == WS_HLAT && WS_END <= 1084 * MiB, "ws map");
constexpr int CW_BAR = 4096;
constexpr int VEC_BINP = 0, VEC_CL = 16384, VEC_LG2 = 16384 + 4096;

constexpr int RING_BYTES = 131072, LDSCTL_OFF = RING_BYTES, MISC_OFF = LDSCTL_OFF + 320, PTR_OFF = LDSCTL_OFF + 1024, LDS_BYTES = 147456;

#ifndef EPI_NT
#define EPI_NT 0
#endif
#if EPI_NT
#define ST16(p, w) __builtin_nontemporal_store((w), (u32x4*)(p))
#else
#define ST16(p, w) (*(u32x4*)(p) = (w))
#endif
__device__ __forceinline__ unsigned cvt_pk_bf16(float lo, float hi) { unsigned r; asm volatile("v_cvt_pk_bf16_f32 %0, %1, %2" : "=v"(r) : "v"(lo), "v"(hi)); return r; }
__device__ __forceinline__ float bf_lo(unsigned w) { return __uint_as_float(w << 16); }
__device__ __forceinline__ float bf_hi(unsigned w) { return __uint_as_float(w & 0xffff0000u); }
__device__ __forceinline__ float fexp(float x) { return __builtin_amdgcn_exp2f(x * 1.44269504089f); }
__device__ __forceinline__ float flog1p(float e) { const float u = 1.0f + e; return u == 1.0f ? e : (__builtin_amdgcn_logf(u) * 0.69314718056f) * e * __builtin_amdgcn_rcpf(u - 1.0f); }
__device__ __forceinline__ float fsigmoid(float x) { return __builtin_amdgcn_rcpf(1.0f + fexp(-x)); }
__device__ __forceinline__ float fsilu(float x) { return x * fsigmoid(x); }
__device__ __forceinline__ float fgelu(float x) { const float u = 0.7978845608f * (x + 0.044715f * x * x * x); return x * fsigmoid(2.0f * u); }
__device__ __forceinline__ float wave_sum(float v) {
#pragma unroll
    for (int o = 1; o < 64; o <<= 1) v += __shfl_xor(v, o);
    return v;
}

namespace pg8 {
constexpr int BM = 256, BK = 64, HALF = 128, HTB = HALF * BK * 2, STAGE_BYTES = 8 * HTB, NXCD = 8, WGM = 8;
__host__ __device__ __forceinline__ int lds_byte(int r, int c) { const int st = (r >> 4) * 2 + (c >> 5), rr = r & 15, cc = c & 31, ob = rr * 64 + cc * 2; return st * 1024 + (ob ^ (((ob >> 9) & 1) << 5)); }
__host__ __device__ __forceinline__ void stage_rc(int b, int& R, int& C) { const int st = b / 1024, sb = b % 1024, swz = sb ^ (((sb >> 9) & 1) << 5); R = (st >> 1) * 16 + swz / 64; C = (st & 1) * 32 + (swz % 64) / 2; }
__host__ __device__ __forceinline__ int perm32(int rho) { const int n = rho >> 4, i = rho & 15; return 8 * (i >> 2) + 4 * n + (i & 3); }

struct UD { const char* A; const char* B; unsigned lda, ldb; int pm, pn, seg; };

struct TileOrder {
    int nM, nN, nseg, G, c;
    __device__ __forceinline__ bool tile(int i, int& pm, int& pn, int& seg) const {
        const int ti = i / nseg; seg = i - ti * nseg;
        const long L = (long)ti * G + c; const int nwg = nM * nN; if (L >= nwg) return false;
        int wgid = (int)L; { const int q = nwg / NXCD, r = nwg % NXCD, xcd = wgid % NXCD, off = wgid / NXCD; wgid = (xcd < r ? xcd * (q + 1) : r * (q + 1) + (xcd - r) * q) + off; }
        const int nig = WGM * nN, gid = wgid / nig, fm = gid * WGM, gsz = (nM - fm) < WGM ? (nM - fm) : WGM;
        pm = fm + ((wgid % nig) % gsz); pn = (wgid % nig) / gsz;
        if ((nM & 63) == 0 && (G & 7) == 0) { pn += 4 * (c & 7); pn -= (pn >= nN) ? nN : 0; pn -= (pn >= nN) ? nN : 0; pn -= (pn >= nN) ? nN : 0; pn -= (pn >= nN) ? nN : 0; }
        return true;
    }
};

template <class Epi, class Sched>
__device__ __forceinline__ void gemm_phase(LAS unsigned char* lds, const int tid, const int nt_in, const Sched& S, const Epi& E) {
    int nt = nt_in; asm volatile("" : "+s"(nt));
    const int wid = __builtin_amdgcn_readfirstlane(tid >> 6), lane = tid & 63, wr = wid >> 2, wc = wid & 3, fr = lane & 15, fq = lane >> 4;
    unsigned RA, RB, C2;
    { int R, C; stage_rc(tid * 16, R, C); RA = (unsigned)(Epi::PERMA ? ((R & 64) + 4 * (R & 15) + ((R >> 4) & 3)) : R); RB = (unsigned)((R & ~31) + perm32(R & 31)); C2 = (unsigned)C * 2u; }
    const unsigned ldsw = (unsigned)wid * 1024u;
    const int aoff = lds_byte(wr * 64 + fr, fq * 8), boff = lds_byte(wc * 32 + fr, fq * 8);
#define PG8_SA(b, h) (((b) * 2 + (h)) * HTB)
#define PG8_SB(b, h) ((4 + (b) * 2 + (h)) * HTB)
#define PG8_STAGE(bufoff, gbase, ld, RR) do { const unsigned _vo = RR * (ld) + C2; _Pragma("unroll") for (int _i = 0; _i < 2; ++_i) \
        __builtin_amdgcn_global_load_lds((const unsigned*)((const char*)(gbase) + (size_t)(_i * 64) * (ld) + (size_t)_vo), (LAS unsigned*)(lds + (bufoff) + ldsw + _i * 8192), 16, 0, 0); } while (0)
#define PG8_LDA(dst, b, h) do { _Pragma("unroll") for (int m = 0; m < 4; ++m) _Pragma("unroll") for (int k = 0; k < 2; ++k) dst[m][k] = *(const LAS bf16x8*)(lds + PG8_SA(b, h) + aoff + m * 2048 + k * 1024); } while (0)
#define PG8_LDB(dst, b, h) do { _Pragma("unroll") for (int n = 0; n < 2; ++n) _Pragma("unroll") for (int k = 0; k < 2; ++k) dst[n][k] = *(const LAS bf16x8*)(lds + PG8_SB(b, h) + boff + n * 2048 + k * 1024); } while (0)
#define PG8_MMA(ai, bj, At, Bt) do { __builtin_amdgcn_s_setprio(1); _Pragma("unroll") for (int m = 0; m < 4; ++m) _Pragma("unroll") for (int n = 0; n < 2; ++n) _Pragma("unroll") for (int k = 0; k < 2; ++k) \
        acc[ai][bj][m][n] = __builtin_amdgcn_mfma_f32_16x16x32_bf16(Bt[n][k], At[m][k], acc[ai][bj][m][n], 0, 0, 0); __builtin_amdgcn_s_setprio(0); } while (0)
#define PG8_WAIT_V(n) asm volatile("s_waitcnt vmcnt(" #n ")" ::: "memory")
#define PG8_WAIT_L(n) asm volatile("s_waitcnt lgkmcnt(" #n ")" ::: "memory")
#define PG8_BAR __builtin_amdgcn_s_barrier()
#define PG8_SCHED __builtin_amdgcn_sched_barrier(0)
    UD cur, nxt; int ui = 0;
    if (!S.next(0, cur)) return;
    f32x4 acc[2][2][4][2];
#pragma unroll
    for (int a = 0; a < 2; ++a)
#pragma unroll
        for (int b = 0; b < 2; ++b)
#pragma unroll
            for (int m = 0; m < 4; ++m)
#pragma unroll
                for (int n = 0; n < 2; ++n) acc[a][b][m][n] = (f32x4){0.f, 0.f, 0.f, 0.f};
    bf16x8 At[4][2], B0[2][2], B1[2][2];
    const size_t kstep = (size_t)(BK * 2);
    PG8_STAGE(PG8_SB(0, 0), cur.B, cur.ldb, RB); PG8_STAGE(PG8_SB(0, 1), cur.B + (size_t)HALF * cur.ldb, cur.ldb, RB);
    PG8_STAGE(PG8_SA(0, 0), cur.A, cur.lda, RA); PG8_STAGE(PG8_SA(0, 1), cur.A + (size_t)HALF * cur.lda, cur.lda, RA);
    if (wr == 1) PG8_BAR;
    PG8_WAIT_V(2); PG8_BAR;
    PG8_STAGE(PG8_SB(1, 0), cur.B + kstep, cur.ldb, RB); PG8_STAGE(PG8_SA(1, 0), cur.A + kstep, cur.lda, RA); PG8_STAGE(PG8_SB(1, 1), cur.B + (size_t)HALF * cur.ldb + kstep, cur.ldb, RB);
    PG8_WAIT_V(6); PG8_BAR;
    for (;;) {
        const bool has_next = S.next(ui + 1, nxt);
        if (!has_next) nxt = cur;
        const char* cA = cur.A; const char* cB = cur.B; const unsigned clda = cur.lda, cldb = cur.ldb;
        for (int t = 0; t < nt; t += 2) {
            const bool last = (t == nt - 2);
            const char* a1 = cA + (size_t)(t + 1) * kstep;
            const char* a2 = last ? nxt.A : cA + (size_t)(t + 2) * kstep; const char* b2 = last ? nxt.B : cB + (size_t)(t + 2) * kstep;
            const unsigned lda2 = last ? nxt.lda : clda, ldb2 = last ? nxt.ldb : cldb;
            const char* a3 = a2 + kstep; const char* b3 = b2 + kstep;
            PG8_LDB(B0, 0, 0); PG8_LDB(B1, 0, 1); PG8_SCHED; PG8_LDA(At, 0, 0); PG8_STAGE(PG8_SA(1, 1), a1 + (size_t)HALF * clda, clda, RA);
            PG8_WAIT_V(8); PG8_WAIT_L(0); PG8_BAR; PG8_MMA(0, 0, At, B0); PG8_MMA(0, 1, At, B1); PG8_BAR; PG8_SCHED;
            PG8_LDA(At, 0, 1); PG8_STAGE(PG8_SB(0, 0), b2, ldb2, RB); PG8_STAGE(PG8_SB(0, 1), b2 + (size_t)HALF * ldb2, ldb2, RB); PG8_STAGE(PG8_SA(0, 0), a2, lda2, RA);
            PG8_WAIT_V(8); PG8_WAIT_L(0); PG8_BAR; PG8_MMA(1, 0, At, B0); PG8_MMA(1, 1, At, B1); PG8_BAR; PG8_SCHED;
            PG8_LDB(B0, 1, 0); PG8_LDB(B1, 1, 1); PG8_SCHED; PG8_LDA(At, 1, 0); PG8_STAGE(PG8_SA(0, 1), a2 + (size_t)HALF * lda2, lda2, RA);
            PG8_WAIT_V(8); PG8_WAIT_L(0); PG8_BAR; PG8_MMA(0, 0, At, B0); PG8_MMA(0, 1, At, B1); PG8_BAR; PG8_SCHED;
            PG8_LDA(At, 1, 1); PG8_STAGE(PG8_SB(1, 0), b3, ldb2, RB); PG8_STAGE(PG8_SB(1, 1), b3 + (size_t)HALF * ldb2, ldb2, RB); PG8_STAGE(PG8_SA(1, 0), a3, lda2, RA);
            PG8_WAIT_V(8); PG8_WAIT_L(0); PG8_BAR; PG8_MMA(1, 0, At, B0); PG8_MMA(1, 1, At, B1); PG8_BAR; PG8_SCHED;
        }
        if (wr == 0) PG8_BAR;
        int tt_ = tid; asm volatile("" : "+v"(tt_)); const int fr_ = tt_ & 15, fq_ = (tt_ >> 4) & 3;
        const bool keep = E(acc, cur, wr, wc, fr_, fq_);
        if (!has_next) break;
        if (!keep) {
#pragma unroll
            for (int a = 0; a < 2; ++a)
#pragma unroll
                for (int b = 0; b < 2; ++b)
#pragma unroll
                    for (int m = 0; m < 4; ++m)
#pragma unroll
                        for (int n = 0; n < 2; ++n) acc[a][b][m][n] = (f32x4){0.f, 0.f, 0.f, 0.f};
        }
        cur = nxt; ++ui;
        if (wr == 1) PG8_BAR;
    }
    PG8_WAIT_V(0);
    PG8_BAR;
#undef PG8_SA
#undef PG8_SB
#undef PG8_STAGE
#undef PG8_LDA
#undef PG8_LDB
#undef PG8_MMA
#undef PG8_WAIT_V
#undef PG8_WAIT_L
#undef PG8_BAR
#undef PG8_SCHED
}
}
using pg8::UD;

#define XB_TMO      128
#define XB_XCNT(j)  (256  + 64 * (j))
#define XB_XSUB(j)  (1280 + 64 * (j))
#define XB_XGEN(j)  (2304 + 64 * (j))
#define XB_TOP      3328
#define XB_TOPGEN   3392
#define XCD_BAR_WORDS 3456
#define XB_SPIN_CAP (1u << 21)
__device__ __forceinline__ unsigned xb_ld(unsigned* p)              { return __hip_atomic_load(p, __ATOMIC_RELAXED, __HIP_MEMORY_SCOPE_AGENT); }
__device__ __forceinline__ unsigned xb_add(unsigned* p, unsigned v) { return __hip_atomic_fetch_add(p, v, __ATOMIC_RELAXED, __HIP_MEMORY_SCOPE_AGENT); }
__device__ __forceinline__ unsigned xb_xcc_id() { return (unsigned)__builtin_amdgcn_s_getreg((3 << 11) | 20) & 0xFu; }
#define XB_SPIN(cond, bar) do { unsigned _sp = 0; while (cond) { __builtin_amdgcn_s_sleep(1); \
    if ((++_sp & 255u) == 0u) { if (xb_ld(&(bar)[XB_TMO])) break; if (_sp > XB_SPIN_CAP) { atomicAdd(&(bar)[XB_TMO], 1u); break; } } } } while (0)
struct XcdBarrier { unsigned* bar; unsigned x; volatile LAS unsigned* st; };
__device__ __forceinline__ XcdBarrier xcd_barrier_post(unsigned* bar, volatile LAS unsigned* st, bool leader) {
    XcdBarrier b; b.bar = bar; b.x = xb_xcc_id(); b.st = st;
    if (leader) (void)xb_add(&bar[XB_XCNT(b.x)], 1u);
    return b;
}
__device__ __forceinline__ void xcd_barrier_complete(unsigned* bar, unsigned x, unsigned& nloc, unsigned& nx) {
    const unsigned G = gridDim.x * gridDim.y * gridDim.z;
    unsigned sum, cnt, mine, sp = 0u;
    for (;;) {
        sum = 0u; cnt = 0u; mine = 0u;
#pragma unroll
        for (unsigned j = 0; j < 16; ++j) { const unsigned c = xb_ld(&bar[XB_XCNT(j)]); sum += c; cnt += (c > 0u) ? 1u : 0u; mine = (j == x) ? c : mine; }
        if (sum == G) break;
        __builtin_amdgcn_s_sleep(1);
        if ((++sp & 255u) == 0u) { if (xb_ld(&bar[XB_TMO])) break; if (sp > XB_SPIN_CAP) { atomicAdd(&bar[XB_TMO], 1u); break; } }
    }
    nloc = mine > 0u ? mine : 1u; nx = cnt > 0u ? cnt : 1u;
}
__device__ __forceinline__ void xcd_barrier(const XcdBarrier& b, bool leader) {
    asm volatile("s_waitcnt vmcnt(0)" ::: "memory");
    __syncthreads();
    if (leader) {
        unsigned* bar = b.bar;
        __builtin_amdgcn_s_waitcnt(0);
        unsigned nloc = b.st[0], nx = b.st[1];
        if (nloc == 0u) { xcd_barrier_complete(bar, b.x, nloc, nx); b.st[0] = nloc; b.st[1] = nx; }
        const unsigned old = xb_add(&bar[XB_XSUB(b.x)], 1u);
        const unsigned gen = old / nloc;
        if (old + 1u == (gen + 1u) * nloc) {
            __builtin_amdgcn_fence(__ATOMIC_RELEASE, "agent");
            asm volatile("s_waitcnt vmcnt(0)" ::: "memory");
            const unsigned og = xb_add(&bar[XB_TOP], 1u);
            const unsigned tg = og / nx;
            if (og + 1u == (tg + 1u) * nx) xb_add(&bar[XB_TOPGEN], 1u);
            else XB_SPIN(xb_ld(&bar[XB_TOPGEN]) == tg, bar);
            __builtin_amdgcn_fence(__ATOMIC_ACQUIRE, "agent");
            xb_add(&bar[XB_XGEN(b.x)], 1u);
            asm volatile("s_waitcnt vmcnt(0)" ::: "memory");
        } else {
            XB_SPIN(xb_ld(&bar[XB_XGEN(b.x)]) == gen, bar);
            __builtin_amdgcn_fence(__ATOMIC_ACQUIRE, "agent");
            asm volatile("s_waitcnt vmcnt(0)" ::: "memory");
        }
    }
    __syncthreads();
}

struct Args { const float* in[26]; float* out; unsigned char* ws; int ph_lo, ph_hi; };
struct Frame {
    LAS unsigned char* lds;
    int tid, lane, wave, G, gw, NGW, gtid, NT;
    unsigned char* ws;
};
struct Pass {
    int nseq, L, Mp, rps;
    const bf16_t* H;
    const float* xin; float* xout;
    int vec;
    int rope, is_ctx, batch, full;
};

__device__ __forceinline__ char* slotp(const Frame& F, int s) { return (char*)F.ws + WS_SLOTS + (size_t)s * SLOT; }
__device__ __forceinline__ const float* inp(const Frame& F, int k) {
    const unsigned long long v = ((const LAS unsigned long long*)(F.lds + PTR_OFF))[k];
    const unsigned lo = __builtin_amdgcn_readfirstlane((unsigned)v), hi = __builtin_amdgcn_readfirstlane((unsigned)(v >> 32));
    return (const float*)(GAS const float*)(((unsigned long long)hi << 32) | lo);
}

struct SchedIn { pg8::TileOrder T; const char* H; const char* W; int part;
    __device__ __forceinline__ bool next(int i, UD& u) const { int pm, pn, seg; if (!T.tile(i, pm, pn, seg)) return false;
        const int gl = pn >> 3; const int g = part == 0 ? (gl < 3 ? gl : 4) : (gl == 0 ? 3 : gl + 4);
        u.pm = pm; u.pn = g * 8 + (pn & 7); u.seg = 0;
        u.A = H + (size_t)pm * 256 * 4096; u.B = W + (size_t)u.pn * 256 * 4096; u.lda = 4096u; u.ldb = 4096u; return true; } };
struct EpiIn {
    static constexpr bool PERMA = true;
    char* slots; const float* bias; const float* rope_tab; const float* lg2; const float* stats; const float* gn; const float* cin; int rope; int rps; int Mp;
    __device__ __forceinline__ bool operator()(f32x4 (&acc)[2][2][4][2], const UD& u, int wr, int wc, int fr, int fq) const {
        const int g = u.pn >> 3, hh = u.pn & 7;
        const int row0 = u.pm * 256 + wr * 64 + 4 * fr, col0 = hh * 256 + wc * 32 + 8 * fq, bcol0 = u.pn * 256 + wc * 32 + 8 * fq;
        f32x4 bv[2][2];
#pragma unroll
        for (int bj = 0; bj < 2; ++bj)
#pragma unroll
            for (int n = 0; n < 2; ++n) bv[bj][n] = *(const f32x4*)(bias + bcol0 + bj * 128 + 4 * n);
        if (g < 2) {
            const float sc = (g == 1) ? 0.0625f : 1.0f;
            bf16_t* base = (bf16_t*)(slots + (size_t)g * SLOT);
            const float* cosr = rope_tab; const float* sinr = rope_tab + 256 * 64; const float* cosc = rope_tab + 2 * 256 * 64; const float* sinc = cosc + 64 * 64;
            const int fo = 16 * wc + 4 * fq;
#pragma unroll
            for (int ai = 0; ai < 2; ++ai) {
                f32x4 cr = (f32x4){1.f, 1.f, 1.f, 1.f}, sr = (f32x4){0.f, 0.f, 0.f, 0.f};
                if (rope) { const int trow = ((u.pm * 256 + ai * 128 + wr * 64) % rps) >> 6; cr = *(const f32x4*)(cosr + trow * 64 + fo); sr = *(const f32x4*)(sinr + trow * 64 + fo); }
#pragma unroll
                for (int m = 0; m < 4; ++m) {
                    f32x4 cc = (f32x4){1.f, 1.f, 1.f, 1.f}, sn = (f32x4){0.f, 0.f, 0.f, 0.f};
                    if (rope) { cc = *(const f32x4*)(cosc + (4 * fr + m) * 64 + fo); sn = *(const f32x4*)(sinc + (4 * fr + m) * 64 + fo); }
                    bf16_t* rowp = base + (size_t)(row0 + ai * 128 + m) * DM + col0;
#pragma unroll
                    for (int bj = 0; bj < 2; ++bj) {
                        const f32x4 x1 = acc[ai][bj][m][0] + bv[bj][0], x2 = acc[ai][bj][m][1] + bv[bj][1];
                        const f32x4 c = bj == 0 ? cr : cc, s = bj == 0 ? sr : sn;
                        const f32x4 y1 = (x1 * c - x2 * s) * sc, y2 = (x1 * s + x2 * c) * sc;
                        acc[ai][bj][m][0] = y1; acc[ai][bj][m][1] = y2;
                        u32x4 w; w.x = cvt_pk_bf16(y1[0], y1[1]); w.y = cvt_pk_bf16(y1[2], y1[3]); w.z = cvt_pk_bf16(y2[0], y2[1]); w.w = cvt_pk_bf16(y2[2], y2[3]);
                        ST16(rowp + bj * 128, w);
                    }
                }
            }
            if (g == 1) {
                const float l2f = lg2[hh], l2b = lg2[8 + hh];
                bf16_t* ktf = (bf16_t*)(slots + 2 * SLOT); bf16_t* ktb = (bf16_t*)(slots + 3 * SLOT);
#pragma unroll
                for (int ai = 0; ai < 2; ++ai) {
                    float wf[4], wb[4];
#pragma unroll
                    for (int m = 0; m < 4; ++m) { const int tl = ai * 128 + wr * 64 + 4 * fr + m; wf[m] = __builtin_amdgcn_exp2f(l2f * (float)(255 - tl)); wb[m] = __builtin_amdgcn_exp2f(l2b * (float)tl); }
#pragma unroll
                    for (int bj = 0; bj < 2; ++bj)
#pragma unroll
                        for (int n = 0; n < 2; ++n)
#pragma unroll
                            for (int j = 0; j < 4; ++j) {
                                const size_t o = (size_t)(col0 + bj * 128 + 4 * n + j) * Mp + row0 + ai * 128;
                                const float v0 = acc[ai][bj][0][n][j], v1 = acc[ai][bj][1][n][j], v2 = acc[ai][bj][2][n][j], v3 = acc[ai][bj][3][n][j];
                                u32x2 w; w.x = cvt_pk_bf16(v0 * wf[0], v1 * wf[1]); w.y = cvt_pk_bf16(v2 * wf[2], v3 * wf[3]); *(u32x2*)(ktf + o) = w;
                                w.x = cvt_pk_bf16(v0 * wb[0], v1 * wb[1]); w.y = cvt_pk_bf16(v2 * wb[2], v3 * wb[3]); *(u32x2*)(ktb + o) = w;
                            }
                }
            }
        } else if (g == 2) {
            bf16_t* vt = (bf16_t*)(slots + 4 * SLOT);
#pragma unroll
            for (int ai = 0; ai < 2; ++ai)
#pragma unroll
                for (int bj = 0; bj < 2; ++bj)
#pragma unroll
                    for (int n = 0; n < 2; ++n)
#pragma unroll
                        for (int j = 0; j < 4; ++j) {
                            const size_t o = (size_t)(col0 + bj * 128 + 4 * n + j) * Mp + row0 + ai * 128; const float b = bv[bj][n][j];
                            u32x2 w; w.x = cvt_pk_bf16(acc[ai][bj][0][n][j] + b, acc[ai][bj][1][n][j] + b); w.y = cvt_pk_bf16(acc[ai][bj][2][n][j] + b, acc[ai][bj][3][n][j] + b); *(u32x2*)(vt + o) = w;
                        }
        } else if (g == 3) {
            bf16_t* O = (bf16_t*)(slots + 7 * SLOT);
            f32x4 gv[2][2];
#pragma unroll
            for (int bj = 0; bj < 2; ++bj)
#pragma unroll
                for (int n = 0; n < 2; ++n) gv[bj][n] = *(const f32x4*)(gn + col0 + bj * 128 + 4 * n);
#pragma unroll
            for (int ai = 0; ai < 2; ++ai) {
#pragma unroll
                for (int mp = 0; mp < 2; ++mp) {
                u32x4 ow[2][2]; float mean[2], rstd[2];
#pragma unroll
                for (int mm = 0; mm < 2; ++mm) { const int row = row0 + ai * 128 + 2 * mp + mm;
                    const f32x4 sa = *(const f32x4*)(stats + (size_t)(row * 8 + hh) * 8), sb = *(const f32x4*)(stats + (size_t)(row * 8 + hh) * 8 + 4);
                    ow[mm][0] = *(const u32x4*)(O + (size_t)row * DM + col0); ow[mm][1] = *(const u32x4*)(O + (size_t)row * DM + col0 + 128);
                    const float s1 = (sa.x + sa.z) + (sb.x + sb.z), s2 = (sa.y + sa.w) + (sb.y + sb.w);
                    mean[mm] = s1 * (1.0f / 256.0f); rstd[mm] = 1.0f / sqrtf(fmaxf(s2 * (1.0f / 256.0f) - mean[mm] * mean[mm], 0.f) + EPS); }
#pragma unroll
                for (int mm = 0; mm < 2; ++mm) { const int m = 2 * mp + mm;
                    bf16_t* rowp = O + (size_t)(row0 + ai * 128 + m) * DM + col0;
#pragma unroll
                    for (int bj = 0; bj < 2; ++bj) {
                        const u32x4 w0 = ow[mm][bj];
                        const f32x4 o0 = (f32x4){bf_lo(w0.x), bf_hi(w0.x), bf_lo(w0.y), bf_hi(w0.y)}, o1 = (f32x4){bf_lo(w0.z), bf_hi(w0.z), bf_lo(w0.w), bf_hi(w0.w)};
                        f32x4 v0 = acc[ai][bj][m][0] + bv[bj][0], v1 = acc[ai][bj][m][1] + bv[bj][1];
#pragma unroll
                        for (int j = 0; j < 4; ++j) { v0[j] = fsilu(v0[j]); v1[j] = fsilu(v1[j]); }
                        v0 = v0 * ((o0 - mean[mm]) * rstd[mm] * gv[bj][0]); v1 = v1 * ((o1 - mean[mm]) * rstd[mm] * gv[bj][1]);
                        u32x4 w; w.x = cvt_pk_bf16(v0[0], v0[1]); w.y = cvt_pk_bf16(v0[2], v0[3]); w.z = cvt_pk_bf16(v1[0], v1[1]); w.w = cvt_pk_bf16(v1[2], v1[3]);
                        ST16(rowp + bj * 128, w);
                    }
                }
                }
            }
        } else if (g == 5) {
            bf16_t* HLf = (bf16_t*)(slots + 5 * SLOT); const bf16_t* ACf = (const bf16_t*)(slots + 1 * SLOT); const bf16_t* HLb = (const bf16_t*)(slots + 2 * SLOT); const bf16_t* ACb = (const bf16_t*)(slots + 3 * SLOT);
#pragma unroll
            for (int ai = 0; ai < 2; ++ai) {
                const int blk = u.pm * 4 + ai * 2 + wr;
#pragma unroll
                for (int bj = 0; bj < 2; ++bj) {
                    const float* cfp = cin + (size_t)blk * DM + col0 + bj * 128; const float* cbp = cin + (size_t)(256 + blk) * DM + col0 + bj * 128;
                    const f32x4 cf0 = *(const f32x4*)cfp, cf1 = *(const f32x4*)(cfp + 4), cb0 = *(const f32x4*)cbp, cb1 = *(const f32x4*)(cbp + 4);
#pragma unroll
                    for (int mp = 0; mp < 2; ++mp) {
                    u32x4 hfw[2], afw[2], hbw[2], abw[2];
#pragma unroll
                    for (int mm = 0; mm < 2; ++mm) { const size_t off = (size_t)(row0 + ai * 128 + 2 * mp + mm) * DM + col0 + bj * 128;
                        hfw[mm] = *(const u32x4*)(HLf + off); afw[mm] = *(const u32x4*)(ACf + off); hbw[mm] = *(const u32x4*)(HLb + off); abw[mm] = *(const u32x4*)(ACb + off); }
#pragma unroll
                    for (int mm = 0; mm < 2; ++mm) { const int m = 2 * mp + mm;
                        const size_t off = (size_t)(row0 + ai * 128 + m) * DM + col0 + bj * 128;
                        const u32x4 hf = hfw[mm], af = afw[mm], hb = hbw[mm], ab = abw[mm];
                        f32x4 v0 = acc[ai][bj][m][0] + bv[bj][0], v1 = acc[ai][bj][m][1] + bv[bj][1];
#pragma unroll
                        for (int j = 0; j < 4; ++j) { v0[j] = fgelu(v0[j]); v1[j] = fgelu(v1[j]); }
                        const f32x4 r0 = (f32x4){bf_lo(hf.x) + bf_lo(hb.x), bf_hi(hf.x) + bf_hi(hb.x), bf_lo(hf.y) + bf_lo(hb.y), bf_hi(hf.y) + bf_hi(hb.y)}
                                       + (f32x4){bf_lo(af.x), bf_hi(af.x), bf_lo(af.y), bf_hi(af.y)} * cf0 + (f32x4){bf_lo(ab.x), bf_hi(ab.x), bf_lo(ab.y), bf_hi(ab.y)} * cb0;
                        const f32x4 r1 = (f32x4){bf_lo(hf.z) + bf_lo(hb.z), bf_hi(hf.z) + bf_hi(hb.z), bf_lo(hf.w) + bf_lo(hb.w), bf_hi(hf.w) + bf_hi(hb.w)}
                                       + (f32x4){bf_lo(af.z), bf_hi(af.z), bf_lo(af.w), bf_hi(af.w)} * cf1 + (f32x4){bf_lo(ab.z), bf_hi(ab.z), bf_lo(ab.w), bf_hi(ab.w)} * cb1;
                        v0 = v0 * r0; v1 = v1 * r1;
                        u32x4 w; w.x = cvt_pk_bf16(v0[0], v0[1]); w.y = cvt_pk_bf16(v0[2], v0[3]); w.z = cvt_pk_bf16(v1[0], v1[1]); w.w = cvt_pk_bf16(v1[2], v1[3]);
                        ST16(HLf + off, w);
                    }
                    }
                }
            }
        } else {
            const int slot = g == 4 ? 5 : g + 2;
            bf16_t* base = (bf16_t*)(slots + (size_t)slot * SLOT);
#pragma unroll
            for (int ai = 0; ai < 2; ++ai)
#pragma unroll
                for (int m = 0; m < 4; ++m) {
                    bf16_t* rowp = base + (size_t)(row0 + ai * 128 + m) * DM + col0;
#pragma unroll
                    for (int bj = 0; bj < 2; ++bj) {
                        f32x4 v0 = acc[ai][bj][m][0] + bv[bj][0], v1 = acc[ai][bj][m][1] + bv[bj][1];
                        if (g >= 6) {
#pragma unroll
                            for (int j = 0; j < 4; ++j) { v0[j] = fsigmoid(v0[j]); v1[j] = fsigmoid(v1[j]); }
                        }
                        u32x4 w; w.x = cvt_pk_bf16(v0[0], v0[1]); w.y = cvt_pk_bf16(v0[2], v0[3]); w.z = cvt_pk_bf16(v1[0], v1[1]); w.w = cvt_pk_bf16(v1[2], v1[3]);
                        ST16(rowp + bj * 128, w);
                    }
                }
        }
        return false;
    }
};

struct SchedGate { pg8::TileOrder T; const char* XL; const char* WG;
    __device__ __forceinline__ bool next(int i, UD& u) const { int pm, pn, seg; if (!T.tile(i, pm, pn, seg)) return false; u.pm = pm; u.pn = pn; u.seg = 0;
        const int k = (pn >> 1) & 7; u.A = XL + (size_t)pm * 256 * 4096 + k * 512; u.B = WG + (size_t)pn * 256 * 512; u.lda = 4096u; u.ldb = 512u; return true; } };
template <int CTRL> __device__ __forceinline__ float dpp_f(float idv, float v) { return __int_as_float(__builtin_amdgcn_update_dpp(__float_as_int(idv), __float_as_int(v), CTRL, 0xF, 0xF, false)); }
template <int CTRL> __device__ __forceinline__ float dpp_z(float v) { return __int_as_float(__builtin_amdgcn_update_dpp(0, __float_as_int(v), CTRL, 0xF, 0xF, true)); }
template <bool BWD> __device__ __forceinline__ void row_scan(float& P, float& H, float& Pe, float& He) {
    float D = P - 1.0f;
#define RS_STEP(d) { const float Dn = dpp_z<(BWD ? 0x100 : 0x110) | (d)>(D), Hn = dpp_z<(BWD ? 0x100 : 0x110) | (d)>(H); H = __builtin_fmaf(P, Hn, H); P = __builtin_fmaf(P, Dn, P); D = P - 1.0f; }
    RS_STEP(1) RS_STEP(2) RS_STEP(4) RS_STEP(8)
#undef RS_STEP
    Pe = dpp_z<(BWD ? 0x100 : 0x110) | 1>(D) + 1.0f; He = dpp_z<(BWD ? 0x100 : 0x110) | 1>(H);
}
struct EpiGate {
    static constexpr bool PERMA = true;
    const bf16_t* XL; bf16_t* HL0; bf16_t* HL1; bf16_t* AC0; bf16_t* AC1; float* PT; float* HT; const float* ba; const float* bx; const float* cl;
    template <bool BWD> __device__ __forceinline__ void run(f32x4 (&acc)[2][2][4][2], const UD& u, int wr, int wc, int fr, int fq) const {
        const int dir = BWD ? 1 : 0, k = (u.pn >> 1) & 7, half = u.pn & 1;
        const int ch0 = 256 * k + 128 * half + 32 * wc + 8 * fq, row0 = u.pm * 256 + wr * 64 + 4 * fr;
        bf16_t* hl = BWD ? HL1 : HL0; bf16_t* ac = BWD ? AC1 : AC0;
#pragma unroll
        for (int ai = 0; ai < 2; ++ai) {
            u32x4 xw[4];
#pragma unroll
            for (int m = 0; m < 4; ++m) xw[m] = *(const u32x4*)(XL + (size_t)(row0 + ai * 128 + m) * DM + ch0);
            unsigned pkh[2][4][2], pka[2][4][2];
#pragma unroll
            for (int n = 0; n < 2; ++n) {
                const f32x4 bav = *(const f32x4*)(ba + dir * DM + ch0 + 4 * n) * -1.44269504089f, bxv = *(const f32x4*)(bx + dir * DM + ch0 + 4 * n) * -1.44269504089f, clv = *(const f32x4*)(cl + dir * DM + ch0 + 4 * n) * 1.44269504089f;
                f32x4 pt, ht;
#pragma unroll
                for (int jp = 0; jp < 2; ++jp) {
                    float av[4][2], uv[4][2];
#pragma unroll
                    for (int m = 0; m < 4; ++m) {
                        const unsigned xx = n ? (jp ? xw[m].w : xw[m].z) : (jp ? xw[m].y : xw[m].x);
#pragma unroll
                        for (int jj = 0; jj < 2; ++jj) { const int j = 2 * jp + jj;
                            const float r = __builtin_amdgcn_rcpf(1.0f + __builtin_amdgcn_exp2f(__builtin_fmaf(acc[ai][0][m][n][j], -1.44269504089f, bav[j]))), ig = __builtin_amdgcn_rcpf(1.0f + __builtin_amdgcn_exp2f(__builtin_fmaf(acc[ai][1][m][n][j], -1.44269504089f, bxv[j])));
                            const float a = __builtin_amdgcn_exp2f(r * clv[j]);
                            av[m][jj] = a; uv[m][jj] = __builtin_amdgcn_sqrtf(fmaxf(1.0f - a * a, 0.f)) * ig * (jj ? bf_hi(xx) : bf_lo(xx)); }
                    }
#pragma unroll
                    for (int jj = 0; jj < 2; ++jj) {
                        float P = 1.0f, H = 0.0f;
#pragma unroll
                        for (int q = 0; q < 4; ++q) { const int m = BWD ? 3 - q : q; H = av[m][jj] * H + uv[m][jj]; P = P * av[m][jj]; uv[m][jj] = H; av[m][jj] = P; }
                        float Pe, He; row_scan<BWD>(P, H, Pe, He);
                        pt[2 * jp + jj] = P; ht[2 * jp + jj] = H;
#pragma unroll
                        for (int m = 0; m < 4; ++m) { uv[m][jj] = uv[m][jj] + av[m][jj] * He; av[m][jj] = av[m][jj] * Pe; }
                    }
#pragma unroll
                    for (int m = 0; m < 4; ++m) { pkh[n][m][jp] = cvt_pk_bf16(uv[m][0], uv[m][1]); pka[n][m][jp] = cvt_pk_bf16(av[m][0], av[m][1]); }
                }
                if (fr == (BWD ? 0 : 15)) { const size_t o = ((size_t)(dir * 256 + u.pm * 4 + ai * 2 + wr)) * DM + ch0 + 4 * n; *(f32x4*)(PT + o) = pt; *(f32x4*)(HT + o) = ht; }
            }
#pragma unroll
            for (int m = 0; m < 4; ++m) {
                const size_t off = (size_t)(row0 + ai * 128 + m) * DM + ch0;
                u32x4 w1, w2; w1.x = pkh[0][m][0]; w1.y = pkh[0][m][1]; w1.z = pkh[1][m][0]; w1.w = pkh[1][m][1]; w2.x = pka[0][m][0]; w2.y = pka[0][m][1]; w2.z = pka[1][m][0]; w2.w = pka[1][m][1];
                *(u32x4*)(hl + off) = w1; *(u32x4*)(ac + off) = w2;
            }
        }
    }
    __device__ __forceinline__ bool operator()(f32x4 (&acc)[2][2][4][2], const UD& u, int wr, int wc, int fr, int fq) const {
        if ((u.pn >> 4) == 0) run<false>(acc, u, wr, wc, fr, fq); else run<true>(acc, u, wr, wc, fr, fq);
        return false;
    }
};

struct SchedAtt { pg8::TileOrder T; const char* Q; const char* K;
    __device__ __forceinline__ bool next(int i, UD& u) const { int pm, pn, seg; if (!T.tile(i, pm, pn, seg)) return false; u.pm = pm; u.pn = pn; u.seg = 0;
        u.A = Q + (size_t)pm * 256 * 4096 + pn * 512; u.B = K + (size_t)pm * 256 * 4096 + pn * 512; u.lda = 4096u; u.ldb = 4096u; return true; } };
struct EpiAtt {
    static constexpr bool PERMA = false;
    bf16_t* P; const float* lg2;
    __device__ __forceinline__ bool operator()(f32x4 (&acc)[2][2][4][2], const UD& u, int wr, int wc, int fr, int fq) const {
        const float l2f = lg2[u.pn], l2b = lg2[8 + u.pn];
        bf16_t* base = P + (size_t)(u.pm * 8 + u.pn) * 65536;
#pragma unroll
        for (int ai = 0; ai < 2; ++ai)
#pragma unroll
            for (int m = 0; m < 4; ++m) {
                const int i = ai * 128 + wr * 64 + m * 16 + fr;
#pragma unroll
                for (int bj = 0; bj < 2; ++bj) {
                    const int j0 = bj * 128 + wc * 32 + 8 * fq;
                    float o[8];
#pragma unroll
                    for (int n = 0; n < 2; ++n)
#pragma unroll
                        for (int j = 0; j < 4; ++j) { const int d = i - (j0 + 4 * n + j);
                            const float w = d > 0 ? __builtin_amdgcn_exp2f(l2f * (float)d) : (d < 0 ? __builtin_amdgcn_exp2f(l2b * (float)(-d)) : 2.0f);
                            o[4 * n + j] = acc[ai][bj][m][n][j] * w; }
                    u32x4 w; w.x = cvt_pk_bf16(o[0], o[1]); w.y = cvt_pk_bf16(o[2], o[3]); w.z = cvt_pk_bf16(o[4], o[5]); w.w = cvt_pk_bf16(o[6], o[7]);
                    *(u32x4*)(base + (size_t)i * 256 + j0) = w;
                }
            }
        return false;
    }
};

struct SchedDS { pg8::TileOrder T; const char* VT; const char* KT0; const char* KT1; unsigned ldT;
    __device__ __forceinline__ bool next(int i, UD& u) const { int pm, pn, seg; if (!T.tile(i, pm, pn, seg)) return false; u.pm = pm; u.pn = pn; u.seg = 0;
        const int dir = pn >> 3, h = pn & 7; u.A = VT + (size_t)h * 256 * ldT + (size_t)pm * 512; u.B = (dir ? KT1 : KT0) + (size_t)h * 256 * ldT + (size_t)pm * 512; u.lda = ldT; u.ldb = ldT; return true; } };
struct EpiDS {
    static constexpr bool PERMA = false;
    bf16_t* S0; bf16_t* S1;
    __device__ __forceinline__ bool operator()(f32x4 (&acc)[2][2][4][2], const UD& u, int wr, int wc, int fr, int fq) const {
        const int dir = u.pn >> 3, h = u.pn & 7;
        bf16_t* base = (dir ? S1 : S0) + (size_t)(u.pm * 8 + h) * 65536;
#pragma unroll
        for (int ai = 0; ai < 2; ++ai)
#pragma unroll
            for (int m = 0; m < 4; ++m) {
                const int i = ai * 128 + wr * 64 + m * 16 + fr;
#pragma unroll
                for (int bj = 0; bj < 2; ++bj) { const f32x4 v0 = acc[ai][bj][m][0], v1 = acc[ai][bj][m][1];
                    u32x4 w; w.x = cvt_pk_bf16(v0[0], v0[1]); w.y = cvt_pk_bf16(v0[2], v0[3]); w.z = cvt_pk_bf16(v1[0], v1[1]); w.w = cvt_pk_bf16(v1[2], v1[3]);
                    *(u32x4*)(base + (size_t)i * 256 + bj * 128 + wc * 32 + 8 * fq) = w; }
            }
        return false;
    }
};

struct SchedOut { pg8::TileOrder T; const char* Q; const char* S0; const char* S1; const char* P; const char* VT; unsigned ldT;
    __device__ __forceinline__ bool next(int i, UD& u) const { int pm, pn, seg; if (!T.tile(i, pm, pn, seg)) return false; u.pm = pm; u.pn = pn; u.seg = seg;
        if (seg < 2) { u.A = Q + (size_t)pm * 256 * 4096 + pn * 512; u.lda = 4096u; u.B = (seg ? S1 : S0) + (size_t)(pm * 8 + pn) * 131072; u.ldb = 512u; }
        else { u.A = P + (size_t)(pm * 8 + pn) * 131072; u.lda = 512u; u.B = VT + (size_t)pn * 256 * ldT + (size_t)pm * 512; u.ldb = ldT; }
        return true; } };
struct EpiOut {
    static constexpr bool PERMA = false;
    bf16_t* O; float* stats; const float* lg2;
    __device__ __forceinline__ bool operator()(f32x4 (&acc)[2][2][4][2], const UD& u, int wr, int wc, int fr, int fq) const {
        const float l2f = lg2[u.pn], l2b = lg2[8 + u.pn];
        if (u.seg < 2) {
#pragma unroll
            for (int ai = 0; ai < 2; ++ai)
#pragma unroll
                for (int m = 0; m < 4; ++m) {
                    const int i = ai * 128 + wr * 64 + m * 16 + fr;
                    const float eb = l2b * (float)(256 - i), ef = l2f * (float)(i + 1);
                    const float s = __builtin_amdgcn_exp2f(u.seg == 0 ? ef - eb : eb);
#pragma unroll
                    for (int bj = 0; bj < 2; ++bj)
#pragma unroll
                        for (int n = 0; n < 2; ++n) acc[ai][bj][m][n] = acc[ai][bj][m][n] * s;
                }
            return true;
        }
#pragma unroll
        for (int ai = 0; ai < 2; ++ai)
#pragma unroll
            for (int m = 0; m < 4; ++m) {
                const int rowg = u.pm * 256 + ai * 128 + wr * 64 + m * 16 + fr;
                float s1 = 0.f, s2 = 0.f;
#pragma unroll
                for (int bj = 0; bj < 2; ++bj) { const f32x4 v0 = acc[ai][bj][m][0], v1 = acc[ai][bj][m][1];
#pragma unroll
                    for (int j = 0; j < 4; ++j) { s1 += v0[j] + v1[j]; s2 += v0[j] * v0[j] + v1[j] * v1[j]; }
                    u32x4 w; w.x = cvt_pk_bf16(v0[0], v0[1]); w.y = cvt_pk_bf16(v0[2], v0[3]); w.z = cvt_pk_bf16(v1[0], v1[1]); w.w = cvt_pk_bf16(v1[2], v1[3]);
                    *(u32x4*)(O + (size_t)rowg * DM + u.pn * 256 + bj * 128 + wc * 32 + 8 * fq) = w; }
                s1 += __shfl_xor(s1, 16); s1 += __shfl_xor(s1, 32); s2 += __shfl_xor(s2, 16); s2 += __shfl_xor(s2, 32);
                if (fq == 0) *(f32x2*)(stats + ((size_t)(rowg * 8 + u.pn) * 4 + wc) * 2) = (f32x2){s1, s2};
            }
        return false;
    }
};

struct SchedMerge { pg8::TileOrder T; const char* YR; const char* YL; const char* WRO; const char* WLO;
    __device__ __forceinline__ bool next(int i, UD& u) const { int pm, pn, seg; if (!T.tile(i, pm, pn, seg)) return false; u.pm = pm; u.pn = pn; u.seg = seg;
        u.A = (seg == 0 ? YR : YL) + (size_t)pm * 256 * 4096; u.B = (seg == 0 ? WRO : WLO) + (size_t)pn * 256 * 4096; u.lda = 4096u; u.ldb = 4096u; return true; } };
struct EpiMerge {
    static constexpr bool PERMA = false;
    const bf16_t* G6; const bf16_t* G7; bf16_t* YM;
    __device__ __forceinline__ bool operator()(f32x4 (&acc)[2][2][4][2], const UD& u, int wr, int wc, int fr, int fq) const {
        const int row0 = u.pm * 256 + wr * 64 + fr, col0 = u.pn * 256 + wc * 32 + 8 * fq;
#pragma unroll
        for (int ai = 0; ai < 2; ++ai)
#pragma unroll
            for (int m = 0; m < 4; ++m)
#pragma unroll
                for (int bj = 0; bj < 2; ++bj) {
                    const size_t off = (size_t)(row0 + ai * 128 + m * 16) * DM + col0 + bj * 128;
                    const u32x4 g7w = *(const u32x4*)(G7 + off);
                    const float g7[8] = {bf_lo(g7w.x), bf_hi(g7w.x), bf_lo(g7w.y), bf_hi(g7w.y), bf_lo(g7w.z), bf_hi(g7w.z), bf_lo(g7w.w), bf_hi(g7w.w)};
                    if (u.seg == 0) {
                        const u32x4 g6w = *(const u32x4*)(G6 + off);
                        const float g6[8] = {bf_lo(g6w.x), bf_hi(g6w.x), bf_lo(g6w.y), bf_hi(g6w.y), bf_lo(g6w.z), bf_hi(g6w.z), bf_lo(g6w.w), bf_hi(g6w.w)};
#pragma unroll
                        for (int n = 0; n < 2; ++n)
#pragma unroll
                            for (int j = 0; j < 4; ++j) acc[ai][bj][m][n][j] *= g6[4 * n + j] * __builtin_amdgcn_rcpf(fmaxf(g7[4 * n + j], 1e-30f));
                    } else {
                        float o[8];
#pragma unroll
                        for (int n = 0; n < 2; ++n)
#pragma unroll
                            for (int j = 0; j < 4; ++j) o[4 * n + j] = acc[ai][bj][m][n][j] * g7[4 * n + j];
                        u32x4 w; w.x = cvt_pk_bf16(o[0], o[1]); w.y = cvt_pk_bf16(o[2], o[3]); w.z = cvt_pk_bf16(o[4], o[5]); w.w = cvt_pk_bf16(o[6], o[7]);
                        ST16(YM + off, w);
                    }
                }
        return u.seg == 0;
    }
};

struct SchedPlain { pg8::TileOrder T; const char* A; const char* B; unsigned lda, ldb;
    __device__ __forceinline__ bool next(int i, UD& u) const { int pm, pn, seg; if (!T.tile(i, pm, pn, seg)) return false; u.pm = pm; u.pn = pn; u.seg = 0;
        u.A = A + (size_t)pm * 256 * lda; u.B = B + (size_t)pn * 256 * ldb; u.lda = lda; u.ldb = ldb; return true; } };
struct EpiPlain {
    static constexpr bool PERMA = false;
    bf16_t* C; int ldc;
    __device__ __forceinline__ bool operator()(f32x4 (&acc)[2][2][4][2], const UD& u, int wr, int wc, int fr, int fq) const {
        const int row0 = u.pm * 256 + wr * 64 + fr, col0 = u.pn * 256 + wc * 32 + 8 * fq;
#pragma unroll
        for (int ai = 0; ai < 2; ++ai)
#pragma unroll
            for (int m = 0; m < 4; ++m)
#pragma unroll
                for (int bj = 0; bj < 2; ++bj) { const f32x4 v0 = acc[ai][bj][m][0], v1 = acc[ai][bj][m][1];
                    u32x4 w; w.x = cvt_pk_bf16(v0[0], v0[1]); w.y = cvt_pk_bf16(v0[2], v0[3]); w.z = cvt_pk_bf16(v1[0], v1[1]); w.w = cvt_pk_bf16(v1[2], v1[3]);
                    ST16(C + (size_t)(row0 + ai * 128 + m * 16) * ldc + col0 + bj * 128, w); }
        return false;
    }
};
struct EpiFfn1 {
    static constexpr bool PERMA = false;
    bf16_t* Fo;
    __device__ __forceinline__ bool operator()(f32x4 (&acc)[2][2][4][2], const UD& u, int wr, int wc, int fr, int fq) const {
        const int row0 = u.pm * 256 + wr * 64 + fr, col0 = u.pn * 128 + wc * 32 + 8 * fq;
#pragma unroll
        for (int ai = 0; ai < 2; ++ai)
#pragma unroll
            for (int m = 0; m < 4; ++m) {
                f32x4 o[2];
#pragma unroll
                for (int n = 0; n < 2; ++n) { const f32x4 av = acc[ai][0][m][n], bv = acc[ai][1][m][n]; f32x4 t = av * -1.44269504089f;
                    t = (f32x4){__builtin_amdgcn_exp2f(t.x), __builtin_amdgcn_exp2f(t.y), __builtin_amdgcn_exp2f(t.z), __builtin_amdgcn_exp2f(t.w)}; t = t + 1.0f;
                    t = (f32x4){__builtin_amdgcn_rcpf(t.x), __builtin_amdgcn_rcpf(t.y), __builtin_amdgcn_rcpf(t.z), __builtin_amdgcn_rcpf(t.w)}; o[n] = (av * bv) * t; }
                u32x4 w; w.x = cvt_pk_bf16(o[0].x, o[0].y); w.y = cvt_pk_bf16(o[0].z, o[0].w); w.z = cvt_pk_bf16(o[1].x, o[1].y); w.w = cvt_pk_bf16(o[1].z, o[1].w);
                ST16(Fo + (size_t)(row0 + ai * 128 + m * 16) * FFH + col0, w);
            }
        return false;
    }
};

__device__ __forceinline__ int rowmap(int kind, int n) {
    if (kind == 0) { if (n < 4096) { const int f = n & 255; const int p = (f & 128) + 32 * ((f >> 4) & 3) + 8 * ((f >> 2) & 3) + 4 * ((f >> 6) & 1) + (f & 3); return (n & ~255) + p; } return n; }
    if (kind == 2) { const int part = n >= FFH ? 1 : 0, cn = n - part * FFH; return (cn >> 7) * 256 + part * 128 + (cn & 127); }
    if (kind == 3 || kind == 4) { return (n >> 7) * 256 + (kind == 4 ? 128 : 0) + (n & 127); }
    return n;
}
__device__ __forceinline__ void transpose_item(const float* W, int K, int N, bf16_t* WT, int kind, LAS float* scr, int item, int lane) {
    const int nblk = N / 32, kb = item / nblk, nb = item % nblk, k0 = 64 * kb, n0 = 32 * nb;
#pragma unroll 8
    for (int i = 0; i < 32; ++i) { const int kk = 2 * i + (lane >> 5); scr[kk * 33 + (lane & 31)] = W[(size_t)(k0 + kk) * N + n0 + (lane & 31)]; }
    asm volatile("s_waitcnt lgkmcnt(0)" ::: "memory");
    const int c = lane & 7;
#pragma unroll
    for (int j = 0; j < 4; ++j) { const int n = (lane >> 3) + 8 * j; const LAS float* s = scr + (8 * c) * 33 + n;
        u32x4 o; o.x = cvt_pk_bf16(s[0 * 33], s[1 * 33]); o.y = cvt_pk_bf16(s[2 * 33], s[3 * 33]); o.z = cvt_pk_bf16(s[4 * 33], s[5 * 33]); o.w = cvt_pk_bf16(s[6 * 33], s[7 * 33]);
        *(u32x4*)(WT + (size_t)rowmap(kind, n0 + n) * K + k0 + 8 * c) = o; }
    asm volatile("s_waitcnt lgkmcnt(0)" ::: "memory");
}
__device__ __forceinline__ void weights_phase(const Frame& F, int l) {
    LAS float* scr = (LAS float*)(F.lds + F.wave * 16384);
    const float* w_in = inp(F, 10) + (size_t)l * DM * INC; const float* w_ro = inp(F, 21) + (size_t)l * DM * DM; const float* w_lo = inp(F, 22) + (size_t)l * DM * DM; const float* w_out = inp(F, 23) + (size_t)l * DM * DM;
    const float* w_f1 = inp(F, 24) + (size_t)l * DM * 2 * FFH; const float* w_f2 = inp(F, 25) + (size_t)l * FFH * DM;
    const float* wa = inp(F, 16) + (size_t)l * 2 * 8 * 65536; const float* wx = inp(F, 18) + (size_t)l * 2 * 8 * 65536;
    constexpr int I_IN = (DM / 64) * (INC / 32), I_SQ = (DM / 64) * (DM / 32), I_F1 = (DM / 64) * (2 * FFH / 32), I_F2 = (FFH / 64) * (DM / 32), I_G = 4 * 8;
    constexpr int NITEMS = I_IN + 3 * I_SQ + I_F1 + I_F2 + 32 * I_G;
    for (int it = F.gw; it < NITEMS; it += F.NGW) {
        int r = it;
        if (r < I_IN) { transpose_item(w_in, DM, INC, (bf16_t*)(F.ws + WS_WIN), 0, scr, r, F.lane); continue; } r -= I_IN;
        if (r < I_SQ) { transpose_item(w_ro, DM, DM, (bf16_t*)(F.ws + WS_WRO), 1, scr, r, F.lane); continue; } r -= I_SQ;
        if (r < I_SQ) { transpose_item(w_lo, DM, DM, (bf16_t*)(F.ws + WS_WLO), 1, scr, r, F.lane); continue; } r -= I_SQ;
        if (r < I_SQ) { transpose_item(w_out, DM, DM, (bf16_t*)(F.ws + WS_WOUT), 1, scr, r, F.lane); continue; } r -= I_SQ;
        if (r < I_F1) { transpose_item(w_f1, DM, 2 * FFH, (bf16_t*)(F.ws + WS_WF1), 2, scr, r, F.lane); continue; } r -= I_F1;
        if (r < I_F2) { transpose_item(w_f2, FFH, DM, (bf16_t*)(F.ws + WS_WF2), 1, scr, r, F.lane); continue; } r -= I_F2;
        { const int mat = r / I_G, sub = r % I_G;
            const int which = mat >> 4, dk = mat & 15;
            transpose_item((which ? wx : wa) + (size_t)dk * 65536, 256, 256, (bf16_t*)(F.ws + WS_WG) + (size_t)dk * 2 * 256 * 256, which ? 4 : 3, scr, sub, F.lane); }
    }
    float* vec = (float*)(F.ws + WS_VEC);
    const float* b_in = inp(F, 11) + (size_t)l * INC; const float* lam = inp(F, 20) + (size_t)l * 2 * DM; const float* rdec = inp(F, 12) + (size_t)l * 16;
    for (int i = F.gtid; i < INC; i += F.NT) vec[VEC_BINP + rowmap(0, i)] = b_in[i];
    for (int i = F.gtid; i < 2 * DM; i += F.NT) { const float x = -lam[i]; const float sp = x > 15.f ? x : flog1p(fexp(x)); vec[VEC_CL + i] = -8.0f * sp; }
    for (int i = F.gtid; i < 16; i += F.NT) { const float x = rdec[i]; const float ls = x < -15.f ? x : -flog1p(fexp(-x)); vec[VEC_LG2 + i] = ls * 1.44269504089f; }
}
__device__ __forceinline__ void mod_partial_phase(const Frame& F) {
    float* modp = (float*)slotp(F, 10);
    const float* c = inp(F, 1); const float* cctx = inp(F, 3);
    for (int it = blockIdx.x; it < 2 * 6 * 32; it += F.G) {
        const int l = it / 192, nb = (it / 32) % 6, ks = it % 32;
        const float* w = inp(F, 4) + (size_t)l * DM * 12288 + (size_t)(ks * 64) * 12288 + nb * 2048 + F.tid * 4;
        f32x4 s0 = (f32x4){0.f, 0.f, 0.f, 0.f}, s1 = s0, s2 = s0;
#pragma unroll 4
        for (int k = 0; k < 64; ++k) { const f32x4 wv = *(const f32x4*)(w + (size_t)k * 12288); const int kk = ks * 64 + k;
            const float c0 = c[kk], c1 = c[DM + kk], c2 = cctx[kk];
            s0 += wv * fsilu(c0); s1 += wv * fsilu(c1); s2 += wv * fsilu(c2); }
        float* o = modp + ((size_t)(l * 32 + ks) * 3) * 12288 + nb * 2048 + F.tid * 4;
        *(f32x4*)(o) = s0; *(f32x4*)(o + 12288) = s1; *(f32x4*)(o + 2 * 12288) = s2;
    }
}
__device__ __forceinline__ void mod_final_phase(const Frame& F) {
    const float* modp = (const float*)slotp(F, 10); float* cv = (float*)(F.ws + WS_MOD);
    for (int i = F.gtid; i < 2 * 3 * DM; i += F.NT) { const int l = i / (3 * DM), v = (i / DM) % 3, n = i % DM;
        float m[6];
#pragma unroll
        for (int q = 0; q < 6; ++q) { float s = inp(F, 5)[l * 12288 + q * DM + n];
            for (int ks = 0; ks < 32; ++ks) s += modp[((size_t)(l * 32 + ks) * 3 + v) * 12288 + q * DM + n];
            m[q] = s; }
        float* o = cv + (size_t)(l * 3 + v) * 12288 + n;
        o[0] = inp(F, 6)[l * DM + n] * (1.0f + m[1]); o[DM] = m[0]; o[2 * DM] = m[2] * inp(F, 7)[l * DM + n];
        o[3 * DM] = inp(F, 8)[l * DM + n] * (1.0f + m[4]); o[4 * DM] = m[3]; o[5 * DM] = m[5] * inp(F, 9)[l * DM + n]; }
}
__device__ __forceinline__ void tables_phase(const Frame& F) {
    float* tab = (float*)(F.ws + WS_ROPE);
    for (int i = F.gtid; i < 320 * 64; i += F.NT) { const int pos = i >> 6, f = i & 63; const int p = pos < 256 ? pos : pos - 256;
        const float inv = __builtin_amdgcn_exp2f(-(float)f * (13.287712379549449f / 64.0f)); const float ang = (float)p * inv; const float rev = ang * 0.15915494309f; const float s = __builtin_amdgcn_sinf(rev), c = __builtin_amdgcn_cosf(rev);
        if (pos < 256) { tab[pos * 64 + f] = c; tab[256 * 64 + pos * 64 + f] = s; } else { tab[2 * 256 * 64 + p * 64 + f] = c; tab[2 * 256 * 64 + 64 * 64 + p * 64 + f] = s; } }
    const f32x4* src = (const f32x4*)inp(F, 2); f32x4* dst = (f32x4*)(F.ws + WS_CTXS);
    for (int i = F.gtid; i < MCTX * DM / 4; i += F.NT) dst[i] = src[i];
}
__device__ __forceinline__ void rows_phase(const Frame& F, const float* xin, float* xout, const bf16_t* y, bf16_t* hout, int nrows, int rows_per_vec, int vec0,
                                           const float* va  , const float* vb  , const float* vc  ) {
    const int half = rows_per_vec / 2;
    for (int it = F.gw; it < nrows / 2; it += F.NGW) {
        const int blk = it / half, r0 = blk * rows_per_vec + (it - blk * half), r1 = r0 + half;
        const int v = vec0 + blk; const float* pa = va + (size_t)v * 12288; const float* pb = vb + (size_t)v * 12288; const float* pc = vc + (size_t)v * 12288;
        f32x4 x0[8], x1[8];
#pragma unroll
        for (int j = 0; j < 8; ++j) { x0[j] = *(const f32x4*)(xin + (size_t)r0 * DM + (64 * j + F.lane) * 4); x1[j] = *(const f32x4*)(xin + (size_t)r1 * DM + (64 * j + F.lane) * 4); }
        if (y) {
            f32x4 y0[8], y1[8]; float s0 = 0.f, s1 = 0.f;
#pragma unroll
            for (int j = 0; j < 8; ++j) { const u32x2 w0 = *(const u32x2*)(y + (size_t)r0 * DM + (64 * j + F.lane) * 4), w1 = *(const u32x2*)(y + (size_t)r1 * DM + (64 * j + F.lane) * 4);
                y0[j] = (f32x4){bf_lo(w0.x), bf_hi(w0.x), bf_lo(w0.y), bf_hi(w0.y)}; y1[j] = (f32x4){bf_lo(w1.x), bf_hi(w1.x), bf_lo(w1.y), bf_hi(w1.y)};
                s0 += (y0[j].x * y0[j].x + y0[j].y * y0[j].y) + (y0[j].z * y0[j].z + y0[j].w * y0[j].w); s1 += (y1[j].x * y1[j].x + y1[j].y * y1[j].y) + (y1[j].z * y1[j].z + y1[j].w * y1[j].w); }
            const float q0 = 1.0f / sqrtf(wave_sum(s0) * (1.0f / DM) + EPS), q1 = 1.0f / sqrtf(wave_sum(s1) * (1.0f / DM) + EPS);
#pragma unroll
            for (int j = 0; j < 8; ++j) { const int c = (64 * j + F.lane) * 4; const f32x4 a = *(const f32x4*)(pa + c);
                x0[j] = x0[j] + a * (y0[j] * q0); x1[j] = x1[j] + a * (y1[j] * q1);
                *(f32x4*)(xout + (size_t)r0 * DM + c) = x0[j]; *(f32x4*)(xout + (size_t)r1 * DM + c) = x1[j]; }
        }
        if (hout) {
            float s0 = 0.f, s1 = 0.f;
#pragma unroll
            for (int j = 0; j < 8; ++j) { s0 += (x0[j].x * x0[j].x + x0[j].y * x0[j].y) + (x0[j].z * x0[j].z + x0[j].w * x0[j].w); s1 += (x1[j].x * x1[j].x + x1[j].y * x1[j].y) + (x1[j].z * x1[j].z + x1[j].w * x1[j].w); }
            const float q0 = 1.0f / sqrtf(wave_sum(s0) * (1.0f / DM) + EPS), q1 = 1.0f / sqrtf(wave_sum(s1) * (1.0f / DM) + EPS);
#pragma unroll
            for (int j = 0; j < 8; ++j) { const int c = (64 * j + F.lane) * 4; const f32x4 b = *(const f32x4*)(pb + c), sh = *(const f32x4*)(pc + c);
                const f32x4 h0 = (x0[j] * q0) * b + sh, h1 = (x1[j] * q1) * b + sh; u32x2 w0, w1; w0.x = cvt_pk_bf16(h0.x, h0.y); w0.y = cvt_pk_bf16(h0.z, h0.w); w1.x = cvt_pk_bf16(h1.x, h1.y); w1.y = cvt_pk_bf16(h1.z, h1.w);
                *(u32x2*)(hout + (size_t)r0 * DM + c) = w0; *(u32x2*)(hout + (size_t)r1 * DM + c) = w1; }
        }
    }
}
__device__ __forceinline__ void rows_phase_upfront(const Frame& F, const float* xin, float* xout, const bf16_t* y, bf16_t* hout, int nrows, int rows_per_vec, int vec0,
                                           const float* va  , const float* vb  , const float* vc  ) {
    const int half = rows_per_vec / 2;
    for (int it = F.gw; it < nrows / 2; it += F.NGW) {
        const int blk = it / half, r0 = 2 * it, r1 = r0 + 1;
        const int v = vec0 + blk; const float* pa = va + (size_t)v * 12288; const float* pb = vb + (size_t)v * 12288; const float* pc = vc + (size_t)v * 12288;
        const int c0 = F.lane * 4;
        f32x4 x0[8], x1[8]; u32x2 w0[8], w1[8]; f32x4 a[8], b[8], sh[8];
#pragma unroll
        for (int j = 0; j < 8; ++j) { x0[j] = *(const f32x4*)(xin + (size_t)r0 * DM + 256 * j + c0); x1[j] = *(const f32x4*)(xin + (size_t)r1 * DM + 256 * j + c0); }
        if (y) {
#pragma unroll
            for (int j = 0; j < 8; ++j) { w0[j] = *(const u32x2*)(y + (size_t)r0 * DM + 256 * j + c0); w1[j] = *(const u32x2*)(y + (size_t)r1 * DM + 256 * j + c0); }
#pragma unroll
            for (int j = 0; j < 8; ++j) a[j] = *(const f32x4*)(pa + 256 * j + c0);
        }
        if (y) asm volatile("" : "+v"(w0[0]), "+v"(w0[1]), "+v"(w0[2]), "+v"(w0[3]), "+v"(w0[4]), "+v"(w0[5]), "+v"(w0[6]), "+v"(w0[7]), "+v"(w1[0]), "+v"(w1[1]), "+v"(w1[2]), "+v"(w1[3]), "+v"(w1[4]), "+v"(w1[5]), "+v"(w1[6]), "+v"(w1[7]) :: "memory");
        else asm volatile("" ::: "memory");
        if (y) {
            float s0 = 0.f, s1 = 0.f;
#pragma unroll
            for (int j = 0; j < 8; ++j) { const float p0 = bf_lo(w0[j].x), p1 = bf_hi(w0[j].x), p2 = bf_lo(w0[j].y), p3 = bf_hi(w0[j].y), t0 = bf_lo(w1[j].x), t1 = bf_hi(w1[j].x), t2 = bf_lo(w1[j].y), t3 = bf_hi(w1[j].y);
                s0 += (p0 * p0 + p1 * p1) + (p2 * p2 + p3 * p3); s1 += (t0 * t0 + t1 * t1) + (t2 * t2 + t3 * t3); }
            const float q0 = __builtin_amdgcn_rsqf(wave_sum(s0) * (1.0f / DM) + EPS), q1 = __builtin_amdgcn_rsqf(wave_sum(s1) * (1.0f / DM) + EPS);
#pragma unroll
            for (int j = 0; j < 8; ++j) { const int c = 256 * j + c0;
                const f32x4 y0 = (f32x4){bf_lo(w0[j].x), bf_hi(w0[j].x), bf_lo(w0[j].y), bf_hi(w0[j].y)}, y1 = (f32x4){bf_lo(w1[j].x), bf_hi(w1[j].x), bf_lo(w1[j].y), bf_hi(w1[j].y)};
                x0[j] = x0[j] + a[j] * (y0 * q0); x1[j] = x1[j] + a[j] * (y1 * q1);
                *(f32x4*)(xout + (size_t)r0 * DM + c) = x0[j]; *(f32x4*)(xout + (size_t)r1 * DM + c) = x1[j]; }
        }
        if (hout) {
#pragma unroll
            for (int j = 0; j < 8; ++j) { b[j] = *(const f32x4*)(pb + 256 * j + c0); sh[j] = *(const f32x4*)(pc + 256 * j + c0); }
            asm volatile("" ::: "memory");
            float s0 = 0.f, s1 = 0.f;
#pragma unroll
            for (int j = 0; j < 8; ++j) { s0 += (x0[j].x * x0[j].x + x0[j].y * x0[j].y) + (x0[j].z * x0[j].z + x0[j].w * x0[j].w); s1 += (x1[j].x * x1[j].x + x1[j].y * x1[j].y) + (x1[j].z * x1[j].z + x1[j].w * x1[j].w); }
            const float q0 = __builtin_amdgcn_rsqf(wave_sum(s0) * (1.0f / DM) + EPS), q1 = __builtin_amdgcn_rsqf(wave_sum(s1) * (1.0f / DM) + EPS);
#pragma unroll
            for (int j = 0; j < 8; ++j) { const int c = 256 * j + c0;
                const f32x4 h0 = (x0[j] * q0) * b[j] + sh[j], h1 = (x1[j] * q1) * b[j] + sh[j]; u32x2 u0, u1; u0.x = cvt_pk_bf16(h0.x, h0.y); u0.y = cvt_pk_bf16(h0.z, h0.w); u1.x = cvt_pk_bf16(h1.x, h1.y); u1.y = cvt_pk_bf16(h1.z, h1.w);
                *(u32x2*)(hout + (size_t)r0 * DM + c) = u0; *(u32x2*)(hout + (size_t)r1 * DM + c) = u1; }
        }
    }
}
__device__ __forceinline__ void ctx_add_partial(const Frame& F, bf16_t* y0, const bf16_t* y1) {
    for (int it = F.gw; it < MCTX / 2; it += F.NGW) {
#pragma unroll
        for (int h = 0; h < 2; ++h) { const size_t rb = (size_t)(it + h * (MCTX / 2)) * DM;
#pragma unroll
            for (int q = 0; q < 4; ++q) { const size_t off = rb + (size_t)(q * 64 + F.lane) * 8; const u32x4 a = *(const u32x4*)(y0 + off), b = *(const u32x4*)(y1 + off); u32x4 w;
                w.x = cvt_pk_bf16(bf_lo(a.x) + bf_lo(b.x), bf_hi(a.x) + bf_hi(b.x)); w.y = cvt_pk_bf16(bf_lo(a.y) + bf_lo(b.y), bf_hi(a.y) + bf_hi(b.y));
                w.z = cvt_pk_bf16(bf_lo(a.z) + bf_lo(b.z), bf_hi(a.z) + bf_hi(b.z)); w.w = cvt_pk_bf16(bf_lo(a.w) + bf_lo(b.w), bf_hi(a.w) + bf_hi(b.w)); *(u32x4*)(y0 + off) = w; } }
    }
    asm volatile("s_waitcnt vmcnt(0)" ::: "memory");
}
__device__ __forceinline__ void conv_phase(const Frame& F, const bf16_t* P4, bf16_t* XL, int Mp, int rps, const float* cw, const float* cb) {
    for (int it = F.gtid; it < (Mp / 8) * 256; it += F.NT) {
        const int rb = it >> 8, cg = it & 255, row0 = rb * 8, t0 = row0 % rps;
        float w[4][8], bias[8];
#pragma unroll
        for (int j = 0; j < 4; ++j) { const f32x4 w0 = *(const f32x4*)(cw + j * DM + cg * 8), w1 = *(const f32x4*)(cw + j * DM + cg * 8 + 4); w[j][0] = w0.x; w[j][1] = w0.y; w[j][2] = w0.z; w[j][3] = w0.w; w[j][4] = w1.x; w[j][5] = w1.y; w[j][6] = w1.z; w[j][7] = w1.w; }
        { const f32x4 b0 = *(const f32x4*)(cb + cg * 8), b1 = *(const f32x4*)(cb + cg * 8 + 4); bias[0] = b0.x; bias[1] = b0.y; bias[2] = b0.z; bias[3] = b0.w; bias[4] = b1.x; bias[5] = b1.y; bias[6] = b1.z; bias[7] = b1.w; }
        u32x4 win[11];
#pragma unroll
        for (int r = 0; r < 11; ++r) { const int tt = t0 + r - 2; win[r] = (tt >= 0 && tt < rps) ? *(const u32x4*)(P4 + (size_t)(row0 + r - 2) * DM + cg * 8) : (u32x4){0u, 0u, 0u, 0u}; }
#pragma unroll
        for (int r = 0; r < 8; ++r) {
            float o[8];
#pragma unroll
            for (int z = 0; z < 8; ++z) o[z] = bias[z];
#pragma unroll
            for (int j = 0; j < 4; ++j) { const u32x4 xw = win[r + j];
                o[0] += bf_lo(xw.x) * w[j][0]; o[1] += bf_hi(xw.x) * w[j][1]; o[2] += bf_lo(xw.y) * w[j][2]; o[3] += bf_hi(xw.y) * w[j][3]; o[4] += bf_lo(xw.z) * w[j][4]; o[5] += bf_hi(xw.z) * w[j][5]; o[6] += bf_lo(xw.w) * w[j][6]; o[7] += bf_hi(xw.w) * w[j][7]; }
            u32x4 wv; wv.x = cvt_pk_bf16(o[0], o[1]); wv.y = cvt_pk_bf16(o[2], o[3]); wv.z = cvt_pk_bf16(o[4], o[5]); wv.w = cvt_pk_bf16(o[6], o[7]);
            *(u32x4*)(XL + (size_t)(row0 + r) * DM + cg * 8) = wv;
        }
    }
}
__device__ __forceinline__ void lru_reduce_phase(const Frame& F, const bf16_t* LAf, const bf16_t* Uf, const bf16_t* LAb, const bf16_t* Ub, int Mp) {
    const int nch = Mp / LCH; float* PS = (float*)(F.ws + WS_PS); float* HE = (float*)(F.ws + WS_HE);
    for (int it = F.gtid; it < 2 * nch * 1024; it += F.NT) {
        const int dir = it / (nch * 1024), c = (it >> 10) % nch, cp = it & 1023;
        const bf16_t* la = (dir ? LAb : LAf) + (size_t)c * LCH * DM + 2 * cp; const bf16_t* uu = (dir ? Ub : Uf) + (size_t)c * LCH * DM + 2 * cp;
        float h0 = 0.f, h1 = 0.f, p0 = 0.f, p1 = 0.f;
#pragma unroll 8
        for (int r = 0; r < LCH; ++r) { const int rr = dir ? LCH - 1 - r : r; const unsigned lw = *(const unsigned*)(la + (size_t)rr * DM), uw = *(const unsigned*)(uu + (size_t)rr * DM);
            const float l0 = bf_lo(lw), l1 = bf_hi(lw); p0 += l0; p1 += l1; h0 = fexp(l0) * h0 + bf_lo(uw); h1 = fexp(l1) * h1 + bf_hi(uw); }
        *(f32x2*)(PS + (size_t)(dir * 128 + c) * DM + 2 * cp) = (f32x2){p0, p1}; *(f32x2*)(HE + (size_t)(dir * 128 + c) * DM + 2 * cp) = (f32x2){h0, h1};
    }
}
__device__ __forceinline__ void lru_final_phase(const Frame& F, const bf16_t* LAf, bf16_t* Uf, const bf16_t* LAb, const bf16_t* Ub, const bf16_t* G5, const Pass& ps) {
    const int nch = ps.Mp / LCH, cps = ps.rps / LCH; const float* PS = (const float*)(F.ws + WS_PS); const float* HE = (const float*)(F.ws + WS_HE); float* HST = (float*)(F.ws + WS_HST);
    for (int it = F.gtid; it < nch * 1024; it += F.NT) {
        const int c = it >> 10, cp = it & 1023, seq = c / cps, cl = c % cps, bidx = ps.is_ctx ? seq : ps.batch;
        float h0 = 0.f, h1 = 0.f;
        if (!ps.is_ctx) { const f32x2 s = *(const f32x2*)(HST + (size_t)(bidx * 2 + 0) * DM + 2 * cp); h0 = s.x; h1 = s.y; }
        for (int cc = seq * cps; cc < c; ++cc) { const f32x2 p = *(const f32x2*)(PS + (size_t)cc * DM + 2 * cp), e = *(const f32x2*)(HE + (size_t)cc * DM + 2 * cp); h0 = fexp(p.x) * h0 + e.x; h1 = fexp(p.y) * h1 + e.y; }
        const size_t base = (size_t)c * LCH * DM + 2 * cp;
#pragma unroll 8
        for (int r = 0; r < LCH; ++r) { const unsigned lw = *(const unsigned*)(LAf + base + (size_t)r * DM), uw = *(const unsigned*)(Uf + base + (size_t)r * DM);
            h0 = fexp(bf_lo(lw)) * h0 + bf_lo(uw); h1 = fexp(bf_hi(lw)) * h1 + bf_hi(uw); *(unsigned*)(Uf + base + (size_t)r * DM) = cvt_pk_bf16(h0, h1); }
        if (ps.is_ctx && cl == cps - 1) *(f32x2*)(HST + (size_t)(bidx * 2 + 0) * DM + 2 * cp) = (f32x2){h0, h1};
        h0 = 0.f; h1 = 0.f;
        if (!ps.is_ctx) { const f32x2 s = *(const f32x2*)(HST + (size_t)(bidx * 2 + 1) * DM + 2 * cp); h0 = s.x; h1 = s.y; }
        for (int cc = seq * cps + cps - 1; cc > c; --cc) { const f32x2 p = *(const f32x2*)(PS + (size_t)(128 + cc) * DM + 2 * cp), e = *(const f32x2*)(HE + (size_t)(128 + cc) * DM + 2 * cp); h0 = fexp(p.x) * h0 + e.x; h1 = fexp(p.y) * h1 + e.y; }
        asm volatile("s_waitcnt vmcnt(0)" ::: "memory");
#pragma unroll 8
        for (int r = LCH - 1; r >= 0; --r) { const unsigned lw = *(const unsigned*)(LAb + base + (size_t)r * DM), uw = *(const unsigned*)(Ub + base + (size_t)r * DM), hw = *(const unsigned*)(Uf + base + (size_t)r * DM), gw = *(const unsigned*)(G5 + base + (size_t)r * DM);
            h0 = fexp(bf_lo(lw)) * h0 + bf_lo(uw); h1 = fexp(bf_hi(lw)) * h1 + bf_hi(uw);
            *(unsigned*)(Uf + base + (size_t)r * DM) = cvt_pk_bf16((h0 + bf_lo(hw)) * bf_lo(gw), (h1 + bf_hi(hw)) * bf_hi(gw)); }
        if (ps.is_ctx && cl == 0) *(f32x2*)(HST + (size_t)(bidx * 2 + 1) * DM + 2 * cp) = (f32x2){h0, h1};
    }
}
__device__ __forceinline__ void lru_carry_phase(const Frame& F, const Pass& ps) {
    float* PT = (float*)(F.ws + WS_PT); float* HT = (float*)(F.ws + WS_HT); float* HST = (float*)(F.ws + WS_HST);
    LAS float* sP = (LAS float*)F.lds; LAS float* sH = sP + 512;
    const int bps = ps.rps / 64, nseg = bps < 16 ? bps : 16, seglen = bps / nseg;
    const int chl = F.tid & 31, seg = F.tid >> 5;
    for (int it = blockIdx.x; it < ps.nseq * 2 * 64; it += F.G) {
        const int cg = it & 63, dir = (it >> 6) & 1, seq = it >> 7, bidx = ps.is_ctx ? seq : ps.batch, ch = cg * 32 + chl;
        float P = 1.0f, H = 0.0f;
        if (seg < nseg) {
#pragma unroll 4
            for (int q = 0; q < seglen; ++q) { const int pos = seg * seglen + q, blk = seq * bps + (dir ? bps - 1 - pos : pos); const size_t o = (size_t)(dir * 256 + blk) * DM + ch;
                const float p = PT[o], e = HT[o]; H = p * H + e; P = P * p; }
        }
        sP[seg * 32 + chl] = P; sH[seg * 32 + chl] = H;
        asm volatile("s_waitcnt lgkmcnt(0)" ::: "memory"); __syncthreads();
        if (seg < nseg) {
            float h = ps.is_ctx ? 0.f : HST[(size_t)(bidx * 2 + dir) * DM + ch];
            for (int s2 = 0; s2 < seg; ++s2) h = sP[s2 * 32 + chl] * h + sH[s2 * 32 + chl];
#pragma unroll 4
            for (int q = 0; q < seglen; ++q) { const int pos = seg * seglen + q, blk = seq * bps + (dir ? bps - 1 - pos : pos); const size_t o = (size_t)(dir * 256 + blk) * DM + ch;
                const float p = PT[o], e = HT[o]; HT[o] = h; h = p * h + e; }
            if (ps.is_ctx && seg == nseg - 1) HST[(size_t)(bidx * 2 + dir) * DM + ch] = h;
        }
        asm volatile("s_waitcnt lgkmcnt(0)" ::: "memory"); __syncthreads();
    }
}
__device__ __forceinline__ void lru_final2_phase(const Frame& F, bf16_t* HLf, const bf16_t* ACf, const bf16_t* HLb, const bf16_t* ACb, const bf16_t* G5, int Mp) {
    const float* CIN = (const float*)(F.ws + WS_HT);
    for (int it = F.gtid; it < Mp * 256; it += F.NT) {
        const int row = it >> 8, cg = it & 255, blk = row >> 6; const size_t off = (size_t)row * DM + cg * 8;
        const u32x4 hf = *(const u32x4*)(HLf + off), af = *(const u32x4*)(ACf + off), hb = *(const u32x4*)(HLb + off), ab = *(const u32x4*)(ACb + off), g = *(const u32x4*)(G5 + off);
        const f32x4 cf0 = *(const f32x4*)(CIN + (size_t)blk * DM + cg * 8), cf1 = *(const f32x4*)(CIN + (size_t)blk * DM + cg * 8 + 4);
        const f32x4 cb0 = *(const f32x4*)(CIN + (size_t)(256 + blk) * DM + cg * 8), cb1 = *(const f32x4*)(CIN + (size_t)(256 + blk) * DM + cg * 8 + 4);
        u32x4 w;
        w.x = cvt_pk_bf16((bf_lo(hf.x) + bf_lo(af.x) * cf0.x + bf_lo(hb.x) + bf_lo(ab.x) * cb0.x) * bf_lo(g.x), (bf_hi(hf.x) + bf_hi(af.x) * cf0.y + bf_hi(hb.x) + bf_hi(ab.x) * cb0.y) * bf_hi(g.x));
        w.y = cvt_pk_bf16((bf_lo(hf.y) + bf_lo(af.y) * cf0.z + bf_lo(hb.y) + bf_lo(ab.y) * cb0.z) * bf_lo(g.y), (bf_hi(hf.y) + bf_hi(af.y) * cf0.w + bf_hi(hb.y) + bf_hi(ab.y) * cb0.w) * bf_hi(g.y));
        w.z = cvt_pk_bf16((bf_lo(hf.z) + bf_lo(af.z) * cf1.x + bf_lo(hb.z) + bf_lo(ab.z) * cb1.x) * bf_lo(g.z), (bf_hi(hf.z) + bf_hi(af.z) * cf1.y + bf_hi(hb.z) + bf_hi(ab.z) * cb1.y) * bf_hi(g.z));
        w.w = cvt_pk_bf16((bf_lo(hf.w) + bf_lo(af.w) * cf1.z + bf_lo(hb.w) + bf_lo(ab.w) * cb1.z) * bf_lo(g.w), (bf_hi(hf.w) + bf_hi(af.w) * cf1.w + bf_hi(hb.w) + bf_hi(ab.w) * cb1.w) * bf_hi(g.w));
        *(u32x4*)(HLf + off) = w;
    }
}
__device__ __forceinline__ void transpose_kv_phase(const Frame& F, const bf16_t* Ksrc, const bf16_t* Vsrc, bf16_t* KTf, bf16_t* KTb, bf16_t* VT, int Mp, const float* lg2) {
    LAS unsigned short* scr = (LAS unsigned short*)(F.lds + F.wave * 16384);
    const int ntt = Mp / 64, nitems = 2 * ntt * 32;
    for (int it = F.gw; it < nitems; it += F.NGW) {
        const int isv = it / (ntt * 32), tt = (it / 32) % ntt, ft = it % 32, tok0 = tt * 64, f0 = ft * 64, h = f0 >> 8;
        const bf16_t* src = isv ? Vsrc : Ksrc;
#pragma unroll
        for (int i = 0; i < 8; ++i) { const int tok = 8 * i + (F.lane >> 3), ch = F.lane & 7; const u32x4 v = *(const u32x4*)(src + (size_t)(tok0 + tok) * DM + f0 + ch * 8);
            LAS unsigned* d = (LAS unsigned*)(scr + tok * 66 + ch * 8); d[0] = v.x; d[1] = v.y; d[2] = v.z; d[3] = v.w; }
        asm volatile("s_waitcnt lgkmcnt(0)" ::: "memory");
        const int q = F.lane & 7; float wf[8], wb[8];
        if (!isv) { const float l2f = lg2[h], l2b = lg2[8 + h];
#pragma unroll
            for (int z = 0; z < 8; ++z) { const int jl = (tok0 + 8 * q + z) & 255; wf[z] = __builtin_amdgcn_exp2f(l2f * (float)(255 - jl)); wb[z] = __builtin_amdgcn_exp2f(l2b * (float)jl); } }
#pragma unroll
        for (int i = 0; i < 8; ++i) { const int f = 8 * i + (F.lane >> 3); float v[8];
#pragma unroll
            for (int z = 0; z < 8; ++z) v[z] = __uint_as_float(((unsigned)scr[(8 * q + z) * 66 + f]) << 16);
            const size_t o = (size_t)(f0 + f) * Mp + tok0 + 8 * q;
            if (isv) { u32x4 w; w.x = cvt_pk_bf16(v[0], v[1]); w.y = cvt_pk_bf16(v[2], v[3]); w.z = cvt_pk_bf16(v[4], v[5]); w.w = cvt_pk_bf16(v[6], v[7]); *(u32x4*)(VT + o) = w; }
            else { u32x4 w; w.x = cvt_pk_bf16(v[0] * wf[0], v[1] * wf[1]); w.y = cvt_pk_bf16(v[2] * wf[2], v[3] * wf[3]); w.z = cvt_pk_bf16(v[4] * wf[4], v[5] * wf[5]); w.w = cvt_pk_bf16(v[6] * wf[6], v[7] * wf[7]); *(u32x4*)(KTf + o) = w;
                w.x = cvt_pk_bf16(v[0] * wb[0], v[1] * wb[1]); w.y = cvt_pk_bf16(v[2] * wb[2], v[3] * wb[3]); w.z = cvt_pk_bf16(v[4] * wb[4], v[5] * wb[5]); w.w = cvt_pk_bf16(v[6] * wb[6], v[7] * wb[7]); *(u32x4*)(KTb + o) = w; } }
        asm volatile("s_waitcnt lgkmcnt(0)" ::: "memory");
    }
}
__device__ __forceinline__ void state_scan_phase(const Frame& F, bf16_t* Sf, bf16_t* Sb, const Pass& ps, const float* lg2) {
    float* SST = (float*)(F.ws + WS_SST);
    for (int it = F.gtid; it < 2 * 8 * 256 * 32; it += F.NT) {
        const int dir = it >> 16, h = (it >> 13) & 7, e = (it >> 5) & 255, d8 = (it & 31) * 8;
        const float g = __builtin_amdgcn_exp2f(256.0f * lg2[dir * 8 + h]);
        bf16_t* Sd = dir ? Sb : Sf;
        for (int seq = 0; seq < ps.nseq; ++seq) {
            const int bidx = ps.is_ctx ? seq : ps.batch;
            float* sst = SST + ((size_t)((bidx * 2 + dir) * 8 + h) * 256 + e) * 256 + d8;
            float s[8];
            if (ps.is_ctx) {
#pragma unroll
                for (int z = 0; z < 8; ++z) s[z] = 0.f;
            } else { const f32x4 a = *(const f32x4*)sst, b = *(const f32x4*)(sst + 4); s[0] = a.x; s[1] = a.y; s[2] = a.z; s[3] = a.w; s[4] = b.x; s[5] = b.y; s[6] = b.z; s[7] = b.w; }
            for (int k0 = 0; k0 < ps.L; k0 += 8) {
                u32x4 w8[8];
#pragma unroll
                for (int i = 0; i < 8; ++i) { const int k = k0 + i; if (k < ps.L) { const int cc = seq * ps.L + (dir ? ps.L - 1 - k : k); w8[i] = *(const u32x4*)(Sd + ((size_t)(cc * 8 + h) * 256 + e) * 256 + d8); } else w8[i] = (u32x4){0u, 0u, 0u, 0u}; }
#pragma unroll
                for (int i = 0; i < 8; ++i) { const int k = k0 + i; if (k < ps.L) { const int cc = seq * ps.L + (dir ? ps.L - 1 - k : k);
                    bf16_t* p = Sd + ((size_t)(cc * 8 + h) * 256 + e) * 256 + d8; const u32x4 w = w8[i];
                    u32x4 o; o.x = cvt_pk_bf16(s[0], s[1]); o.y = cvt_pk_bf16(s[2], s[3]); o.z = cvt_pk_bf16(s[4], s[5]); o.w = cvt_pk_bf16(s[6], s[7]); *(u32x4*)p = o;
                    s[0] = g * s[0] + bf_lo(w.x); s[1] = g * s[1] + bf_hi(w.x); s[2] = g * s[2] + bf_lo(w.y); s[3] = g * s[3] + bf_hi(w.y); s[4] = g * s[4] + bf_lo(w.z); s[5] = g * s[5] + bf_hi(w.z); s[6] = g * s[6] + bf_lo(w.w); s[7] = g * s[7] + bf_hi(w.w); } }
            }
            if (ps.is_ctx) { *(f32x4*)sst = (f32x4){s[0], s[1], s[2], s[3]}; *(f32x4*)(sst + 4) = (f32x4){s[4], s[5], s[6], s[7]}; }
        }
    }
}
__device__ __forceinline__ void yr_phase(const Frame& F, bf16_t* O, const bf16_t* G3, const float* stats, const float* gn, int Mp) {
    for (int it = F.gtid; it < Mp * 256; it += F.NT) {
        const int row = it >> 8, cg = it & 255, h = cg >> 5;
        const f32x4 a = *(const f32x4*)(stats + (size_t)(row * 8 + h) * 8), b = *(const f32x4*)(stats + (size_t)(row * 8 + h) * 8 + 4);
        const float s1 = (a.x + a.z) + (b.x + b.z), s2 = (a.y + a.w) + (b.y + b.w);
        const float mean = s1 * (1.0f / 256.0f), var = fmaxf(s2 * (1.0f / 256.0f) - mean * mean, 0.f), rstd = 1.0f / sqrtf(var + EPS);
        const size_t off = (size_t)row * DM + cg * 8; const u32x4 ow = *(const u32x4*)(O + off), gw = *(const u32x4*)(G3 + off);
        const f32x4 g0 = *(const f32x4*)(gn + cg * 8), g1 = *(const f32x4*)(gn + cg * 8 + 4);
        u32x4 w; w.x = cvt_pk_bf16(bf_lo(gw.x) * (bf_lo(ow.x) - mean) * rstd * g0.x, bf_hi(gw.x) * (bf_hi(ow.x) - mean) * rstd * g0.y);
        w.y = cvt_pk_bf16(bf_lo(gw.y) * (bf_lo(ow.y) - mean) * rstd * g0.z, bf_hi(gw.y) * (bf_hi(ow.y) - mean) * rstd * g0.w);
        w.z = cvt_pk_bf16(bf_lo(gw.z) * (bf_lo(ow.z) - mean) * rstd * g1.x, bf_hi(gw.z) * (bf_hi(ow.z) - mean) * rstd * g1.y);
        w.w = cvt_pk_bf16(bf_lo(gw.w) * (bf_lo(ow.w) - mean) * rstd * g1.z, bf_hi(gw.w) * (bf_hi(ow.w) - mean) * rstd * g1.w);
        *(u32x4*)(O + off) = w;
    }
}

#define OPQ_S(x) do { (x) = __builtin_amdgcn_readfirstlane(x); asm volatile("" : "+s"(x)); } while (0)
#define OPQ_S64(x) do { unsigned lo__ = __builtin_amdgcn_readfirstlane((unsigned)(x)), hi__ = __builtin_amdgcn_readfirstlane((unsigned)((x) >> 32)); asm volatile("" : "+s"(lo__), "+s"(hi__)); (x) = ((unsigned long long)hi__ << 32) | lo__; } while (0)
__device__ __forceinline__ void make_pass(const Frame& F, const Args& args, int l, int pi, Pass& ps) {
    if (pi == 0) { ps.nseq = 2; ps.L = 1; ps.Mp = MCTX; ps.rps = CTXL; ps.H = (const bf16_t*)(F.ws + WS_HCTX); ps.xin = (const float*)(F.ws + WS_CTXS); ps.xout = (float*)(F.ws + WS_CTXS);
        ps.vec = 2; ps.rope = 0; ps.is_ctx = 1; ps.batch = 0; ps.full = (l + 1 < DEPTH); }
    else { const int b = pi - 1; ps.nseq = 1; ps.L = SEQ / 256; ps.Mp = SEQ; ps.rps = SEQ; ps.H = (const bf16_t*)(F.ws + WS_HLAT) + (size_t)b * SEQ * DM;
        ps.xin = (l == 0 ? inp(F, 0) : (const float*)args.out) + (size_t)b * SEQ * DM; ps.xout = args.out + (size_t)b * SEQ * DM; ps.vec = b; ps.rope = 1; ps.is_ctx = 0; ps.batch = b; ps.full = 1; }
}
#ifndef PH_MASK
#define PH_MASK 0xffffffffu
#endif
#define PHON(k) ((PH_MASK >> (k)) & 1u)
#ifndef DUP_MASK
#define DUP_MASK 0u
#endif
#define NREP(k) (((DUP_MASK >> (k)) & 1u) ? 2 : 1)
__global__ void __launch_bounds__(512, 2) mk_fwd(Args args) {
    extern __shared__ __attribute__((aligned(16))) unsigned char lds_raw[];
    {
        const int tid0 = threadIdx.x;
        for (int u = tid0; u < (LDS_BYTES - LDSCTL_OFF) / 4; u += 512) ((LAS unsigned*)((LAS unsigned char*)lds_raw + LDSCTL_OFF))[u] = 0u;
        __syncthreads();
        if (tid0 == 0) {
            LAS unsigned long long* tab = (LAS unsigned long long*)((LAS unsigned char*)lds_raw + PTR_OFF);
#pragma unroll
            for (int k = 0; k < 26; ++k) tab[k] = (unsigned long long)args.in[k];
        }
        __syncthreads();
    }
    const int lo = args.ph_lo, hi = args.ph_hi;
    const int wave0 = __builtin_amdgcn_readfirstlane((int)threadIdx.x >> 6);
#define LANE_ID() ({ int l__; asm volatile("v_mbcnt_lo_u32_b32 %0, -1, 0\n\tv_mbcnt_hi_u32_b32 %0, -1, %0" : "=v"(l__)); l__; })
    if (hi - lo > 1) (void)xcd_barrier_post((unsigned*)(args.ws + WS_CTL) + CW_BAR, (volatile LAS unsigned*)((LAS unsigned char*)lds_raw + MISC_OFF) + 8, threadIdx.x == 0);
    int pc = 0;
#define RUN (pc >= lo && pc < hi)
#define ENDPH do { if (RUN && pc + 1 < hi) { XcdBarrier b_; b_.bar = (unsigned*)(args.ws + WS_CTL) + CW_BAR; b_.x = xb_xcc_id(); b_.st = (volatile LAS unsigned*)((LAS unsigned char*)lds_raw + MISC_OFF) + 8; xcd_barrier(b_, wave0 == 0 && LANE_ID() == 0); } ++pc; } while (0)
#define LOCALS Frame F; { int tid_ = wave0 * 64 + LANE_ID(); asm volatile("" : "+v"(tid_)); unsigned long long ws_ = (unsigned long long)args.ws; OPQ_S64(ws_); F.lds = (LAS unsigned char*)lds_raw; F.tid = tid_; F.lane = tid_ & 63; F.wave = wave0; \
        F.G = gridDim.x; F.gw = blockIdx.x * 8 + F.wave; F.NGW = F.G * 8; F.gtid = blockIdx.x * 512 + tid_; F.NT = F.G * 512; F.ws = (unsigned char*)(GAS unsigned char*)ws_; } int l_ = l; OPQ_S(l_); const int c = (int)blockIdx.x; float* mod = (float*)(F.ws + WS_MOD); const float* vec = (const float*)(F.ws + WS_VEC); const float* modl = mod + (size_t)l_ * 3 * 12288; (void)vec; (void)modl; (void)c
#define PASSLOCALS LOCALS; int pi_ = pi; OPQ_S(pi_); Pass ps; make_pass(F, args, l_, pi_, ps); const int nM = ps.Mp / 256; const unsigned ldT = (unsigned)ps.Mp * 2u; (void)nM; (void)ldT
#define SL(k) ((bf16_t*)slotp(F, (k)))

    { const int l = 0; if (RUN) { if (PHON(0)) for (int rep_ = 0; rep_ < NREP(0); ++rep_) { LOCALS; mod_partial_phase(F); tables_phase(F); } } ENDPH;
    if (RUN) { if (PHON(0)) for (int rep_ = 0; rep_ < NREP(0); ++rep_) { LOCALS; mod_final_phase(F); } } ENDPH; }

    for (int lx = 0; lx <= DEPTH; ++lx) {
        if (RUN) {
            if (lx > 0) { const int l = lx - 1; if (PHON(19)) { LOCALS;
                const bool more = (l_ + 1 < DEPTH); const float* modn = mod + (size_t)(more ? l_ + 1 : l_) * 3 * 12288;
                rows_phase(F, args.out, args.out, (const bf16_t*)slotp(F, 6), more ? (bf16_t*)(F.ws + WS_HLAT) : nullptr, MLAT, SEQ, 0, modl + 5 * DM, modn, modn + DM);
                if (more) { ctx_add_partial(F, (bf16_t*)slotp(F, 9), (const bf16_t*)slotp(F, 10)); }
                if (more) rows_phase(F, (const float*)(F.ws + WS_CTXS), (float*)(F.ws + WS_CTXS), (const bf16_t*)slotp(F, 9), (bf16_t*)(F.ws + WS_HCTX), MCTX, MCTX, 2, modl + 5 * DM, modn, modn + DM); } }
            if (lx < DEPTH) { const int l = lx; if (PHON(1)) for (int rep_ = 0; rep_ < NREP(1); ++rep_) { LOCALS;
                weights_phase(F, l_);
                if (l_ == 0) {
                    rows_phase(F, inp(F, 0), nullptr, nullptr, (bf16_t*)(F.ws + WS_HLAT), MLAT, SEQ, 0, modl, modl, modl + DM);
                    rows_phase(F, inp(F, 2), nullptr, nullptr, (bf16_t*)(F.ws + WS_HCTX), MCTX, MCTX, 2, modl, modl, modl + DM);
                } } }
        } ENDPH;
        if (lx == DEPTH) break;
        const int l = lx;

        for (int px = 0; px <= 3; ++px) {
            if (RUN) { for (int step_ = 0; step_ < 2; ++step_) { const bool thin_ = ((step_ ^ (int)(blockIdx.x >> 3)) & 1) == 0;
                if (thin_) { if (px > 0) { const int pi = px - 1; if (PHON(16)) { PASSLOCALS; if (ps.full) rows_phase_upfront(F, ps.xin, ps.xout, SL(10), (bf16_t*)ps.H, ps.Mp, ps.Mp, ps.vec, modl + 2 * DM, modl + 3 * DM, modl + 4 * DM); } } }
                else { if (px < 3) { const int pi = px; if (PHON(2)) for (int rep_ = 0; rep_ < NREP(2); ++rep_) { PASSLOCALS; SchedIn S{{nM, 32, 1, F.G, c}, (const char*)ps.H, (const char*)(F.ws + WS_WIN), 0};
                    EpiIn E{slotp(F, 0), vec + VEC_BINP, (const float*)(F.ws + WS_ROPE), vec + VEC_LG2, (const float*)(F.ws + WS_STATS), inp(F, 13) + l_ * DM, (const float*)(F.ws + WS_HT), ps.rope, ps.rps, ps.Mp};
                    pg8::gemm_phase(F.lds, F.tid, 32, S, E); } } }
            } } ENDPH;
            if (px == 3) break;
            const int pi = px;
            if (RUN) { for (int step_ = 0; step_ < 2; ++step_) { const bool thin_ = ((step_ ^ (int)(blockIdx.x >> 3)) & 1) == 0;
                if (thin_) { if (PHON(3)) for (int rep_ = 0; rep_ < NREP(3); ++rep_) { PASSLOCALS; conv_phase(F, SL(5), SL(7), ps.Mp, ps.rps, inp(F, 14) + l_ * 4 * DM, inp(F, 15) + l_ * DM); } }
                else {
                if (PHON(8)) for (int rep_ = 0; rep_ < NREP(8); ++rep_) { PASSLOCALS; SchedAtt S{{nM, 8, 1, F.G, c}, (const char*)SL(0), (const char*)SL(1)}; EpiAtt E{SL(8), vec + VEC_LG2}; pg8::gemm_phase(F.lds, F.tid, 4, S, E); }
                if (PHON(9)) for (int rep_ = 0; rep_ < NREP(9); ++rep_) { PASSLOCALS; SchedDS S{{nM, 16, 1, F.G, c}, (const char*)SL(4), (const char*)SL(2), (const char*)SL(3), ldT}; EpiDS E{SL(9), SL(10)}; pg8::gemm_phase(F.lds, F.tid, 4, S, E); }
                } } } ENDPH;
            if (RUN) { for (int step_ = 0; step_ < 2; ++step_) { const bool thin_ = ((step_ ^ (int)(blockIdx.x >> 3)) & 1) == 0;
                if (thin_) { if (PHON(10)) { PASSLOCALS; state_scan_phase(F, SL(9), SL(10), ps, vec + VEC_LG2); } }
                else { if (PHON(4)) for (int rep_ = 0; rep_ < NREP(4); ++rep_) { PASSLOCALS; SchedGate S{{nM, 32, 1, F.G, c}, (const char*)SL(7), (const char*)(F.ws + WS_WG)};
                    EpiGate E{SL(7), SL(5), SL(2), SL(1), SL(3), (float*)(F.ws + WS_PT), (float*)(F.ws + WS_HT), inp(F, 17) + l_ * 2 * DM, inp(F, 19) + l_ * 2 * DM, vec + VEC_CL};
                    pg8::gemm_phase(F.lds, F.tid, 4, S, E); } }
            } } ENDPH;
            if (RUN) {
                if (PHON(5)) { PASSLOCALS; lru_carry_phase(F, ps); }
                if (PHON(11)) for (int rep_ = 0; rep_ < NREP(11); ++rep_) { PASSLOCALS; if (ps.full) { SchedOut S{{nM, 8, 3, F.G, c}, (const char*)SL(0), (const char*)SL(9), (const char*)SL(10), (const char*)SL(8), (const char*)SL(4), ldT}; EpiOut E{SL(7), (float*)(F.ws + WS_STATS), vec + VEC_LG2}; pg8::gemm_phase(F.lds, F.tid, 4, S, E); } }
            } ENDPH;
            if (RUN) {
                if (PHON(12)) { PASSLOCALS; if (ps.full) { SchedIn S{{nM, 32, 1, F.G, c}, (const char*)ps.H, (const char*)(F.ws + WS_WIN), 1};
                    EpiIn E{slotp(F, 0), vec + VEC_BINP, (const float*)(F.ws + WS_ROPE), vec + VEC_LG2, (const float*)(F.ws + WS_STATS), inp(F, 13) + l_ * DM, (const float*)(F.ws + WS_HT), 0, ps.rps, ps.Mp};
                    pg8::gemm_phase(F.lds, F.tid, 32, S, E); } }
            } ENDPH;
            if (RUN) { if (PHON(14)) for (int rep_ = 0; rep_ < NREP(14); ++rep_) { PASSLOCALS; if (ps.full) { SchedMerge S{{nM, 8, 2, F.G, c}, (const char*)SL(7), (const char*)SL(5), (const char*)(F.ws + WS_WRO), (const char*)(F.ws + WS_WLO)}; EpiMerge E{SL(8), SL(9), SL(0)};
                pg8::gemm_phase(F.lds, F.tid, 32, S, E); } } } ENDPH;
            if (RUN) { if (PHON(15)) for (int rep_ = 0; rep_ < NREP(15); ++rep_) { PASSLOCALS; if (ps.full) { SchedPlain S{{nM, 8, 1, F.G, c}, (const char*)SL(0), (const char*)(F.ws + WS_WOUT), 4096u, 4096u}; EpiPlain E{SL(10), DM}; pg8::gemm_phase(F.lds, F.tid, 32, S, E); } } } ENDPH;
        }
        if (RUN) { if (PHON(17)) for (int rep_ = 0; rep_ < NREP(17); ++rep_) { LOCALS; const int nparts = (l_ + 1 < DEPTH) ? 2 : 1; for (int part = 0; part < nparts; ++part) {
            const char* Hp = part ? (const char*)(F.ws + WS_HCTX) : (const char*)(F.ws + WS_HLAT); const int nM = part ? MCTX / 256 : MLAT / 256;
            SchedPlain S{{nM, 44, 1, F.G, c}, Hp, (const char*)(F.ws + WS_WF1), 4096u, 4096u}; EpiFfn1 E{(bf16_t*)slotp(F, part ? 8 : 0)}; pg8::gemm_phase(F.lds, F.tid, 32, S, E); } } } ENDPH;
        if (RUN) { if (PHON(18)) for (int rep_ = 0; rep_ < NREP(18); ++rep_) { LOCALS; const int nparts = (l_ + 1 < DEPTH) ? 3 : 1; for (int part = 0; part < nparts; ++part) {
            const int nM = part ? MCTX / 256 : MLAT / 256, kh = part == 2 ? 1 : 0; const int cc = (kh && F.G >= 32) ? (c + F.G - 16) % F.G : c;
            SchedPlain S{{nM, 8, 1, F.G, cc}, (const char*)slotp(F, part ? 8 : 0) + (size_t)kh * 44 * 128, (const char*)(F.ws + WS_WF2) + (size_t)kh * 44 * 128, (unsigned)FFH * 2u, (unsigned)FFH * 2u}; EpiPlain E{(bf16_t*)slotp(F, part ? 9 + kh : 6), DM}; pg8::gemm_phase(F.lds, F.tid, part ? 44 : 88, S, E); } } } ENDPH;
    }
#undef RUN
#undef ENDPH
}

extern "C" void kernel_launch(void* const* d_in, const int* in_sizes, int n_in, void* d_out, int out_size, void* d_ws, size_t ws_size, hipStream_t stream) {
    static int grid = 0;
    if (grid == 0) {
        if (n_in != 26 || ws_size < WS_END) { fprintf(stderr, "kernel_launch: need 26 inputs and >= %zu bytes of workspace (got %d, %zu)\n", (size_t)WS_END, n_in, ws_size); grid = -1; return; }
        int dev = 0, cus = 0, per_cu = 0;
        if (hipGetDevice(&dev) != hipSuccess || hipDeviceGetAttribute(&cus, hipDeviceAttributeMultiprocessorCount, dev) != hipSuccess) { grid = -1; return; }
        if (hipFuncSetAttribute((const void*)mk_fwd, hipFuncAttributeMaxDynamicSharedMemorySize, LDS_BYTES) != hipSuccess) { fprintf(stderr, "kernel_launch: hipFuncSetAttribute failed\n"); grid = -1; return; }
        if (hipOccupancyMaxActiveBlocksPerMultiprocessor(&per_cu, (const void*)mk_fwd, 512, LDS_BYTES) != hipSuccess || per_cu < 1) fprintf(stderr, "kernel_launch: occupancy query reports %d\n", per_cu);
        (void)hipGetLastError();
        grid = cus;
    }
    if (grid < 0) return;
    (void)hipMemsetAsync((char*)d_ws + WS_CTL, 0, CTL_ZERO_BYTES, stream);
    Args a{};
    for (int i = 0; i < 26; ++i) a.in[i] = (const float*)d_in[i];
    a.out = (float*)d_out; a.ws = (unsigned char*)d_ws;
#if MK_PER_PHASE
    for (int k = 0; k < 128; ++k) { a.ph_lo = k; a.ph_hi = k + 1; hipLaunchKernelGGL(mk_fwd, dim3(grid), dim3(512), LDS_BYTES, stream, a); }
#else
    a.ph_lo = 0; a.ph_hi = 1 << 20;
    hipLaunchKernelGGL(mk_fwd, dim3(grid), dim3(512), LDS_BYTES, stream, a);
#endif
}
```
